# Optimizing an MI355X kernel written in HIP

```python
import jax, jax.numpy as jnp
from jax import lax
import numpy as np

D_MODEL = 1024
BATCH = 8
SEQ = 2048
DEPTH = 1


N_MEM = 256
GRID_W = 64
HEAD_DIM = 64
ATTN_HEADS = 8
KV_HEADS = 2
ATTN_WIDTH = ATTN_HEADS * HEAD_DIM
KV_WIDTH = KV_HEADS * HEAD_DIM
CONV_WIDTH = D_MODEL - ATTN_WIDTH
CONV_GROUPS = 8
CONV_K = 31
MEM_HEADS = 4
MEM_HEAD_DIM = D_MODEL // MEM_HEADS
D_FF = 4 * D_MODEL
Q_BLOCK = 128
AXIS_DIM = HEAD_DIM // 2
ROPE_THETA = 10000.0
EPS = 1e-5
ALPHA = (2 * DEPTH) ** 0.25
BETA = (8 * DEPTH) ** -0.25
IN_COLS = ATTN_WIDTH + 2 * KV_WIDTH + 2 * CONV_WIDTH

kernel_name = 'hybrid_gqa_conformer_deepnorm_encoder'


def _dense(key, shape, fan_in, scale=1.0):
    return jax.random.normal(key, shape, jnp.float32) * (scale * fan_in ** -0.5)


def _gain(key, shape):
    return 1.0 + 0.02 * jax.random.normal(key, shape, jnp.float32)


def _bias(key, shape):
    return 0.02 * jax.random.normal(key, shape, jnp.float32)


def _layernorm(x, g, b):
    xf = x.astype(jnp.float32)
    mu = jnp.mean(xf, axis=-1, keepdims=True)
    var = jnp.mean(jnp.square(xf - mu), axis=-1, keepdims=True)
    return ((xf - mu) * lax.rsqrt(var + EPS) * g + b).astype(x.dtype)


def _rmsnorm(x, g):
    xf = x.astype(jnp.float32)
    return (xf * lax.rsqrt(jnp.mean(jnp.square(xf), axis=-1, keepdims=True) + EPS) * g).astype(x.dtype)


def _group_rms(y, n_groups, g):
    b, s, w = y.shape
    yf = y.astype(jnp.float32).reshape(b, s, n_groups, w // n_groups)
    yf = yf * lax.rsqrt(jnp.mean(jnp.square(yf), axis=-1, keepdims=True) + EPS)
    return (yf.reshape(b, s, w) * g).astype(y.dtype)


def _axial_rotary(seq_len):
    rows = seq_len // GRID_W
    row_ids = jnp.repeat(jnp.arange(rows, dtype=jnp.int32), GRID_W)
    col_ids = jnp.tile(jnp.arange(GRID_W, dtype=jnp.int32), rows)
    inv = ROPE_THETA ** (-jnp.arange(0, AXIS_DIM, 2, dtype=jnp.float32) / AXIS_DIM)
    ang = jnp.concatenate([row_ids[:, None].astype(jnp.float32) * inv,
                           col_ids[:, None].astype(jnp.float32) * inv], axis=-1)
    return jnp.cos(ang), jnp.sin(ang)


def _rope(x, cos, sin):
    xf = x.astype(jnp.float32).reshape(*x.shape[:-1], HEAD_DIM // 2, 2)
    x1, x2 = xf[..., 0], xf[..., 1]
    c, s = cos[:, None, :], sin[:, None, :]
    out = jnp.stack([x1 * c - x2 * s, x1 * s + x2 * c], axis=-1).reshape(x.shape)
    return out.astype(x.dtype)


def _gqa_blocked(q, k, v):
    b, s = q.shape[0], q.shape[1]
    nb = s // Q_BLOCK
    grp = ATTN_HEADS // KV_HEADS
    qb = q.reshape(b, nb, Q_BLOCK, KV_HEADS, grp, HEAD_DIM).transpose(1, 0, 3, 4, 2, 5)
    scale = HEAD_DIM ** -0.5

    def one_block(q_blk):
        sc = jnp.einsum('bkgqd,bskd->bkgqs', q_blk, k).astype(jnp.float32) * scale
        p = jax.nn.softmax(sc, axis=-1).astype(v.dtype)
        return jnp.einsum('bkgqs,bskd->bkgqd', p, v)

    o = lax.map(one_block, qb)
    return o.transpose(1, 0, 4, 2, 3, 5).reshape(b, s, ATTN_WIDTH)


def _depthwise_conv(u, w, bias):
    y = lax.conv_general_dilated(u, w[:, None, :], window_strides=(1,),
                                 padding=[(CONV_K // 2, CONV_K // 2)],
                                 dimension_numbers=('NWC', 'WIO', 'NWC'),
                                 feature_group_count=CONV_WIDTH)
    return y + bias


def _hybrid_mixer(h, cos, sin, w_in, q_norm_g, k_norm_g, conv_w, conv_b, conv_ln_g, conv_ln_b,
                  attn_out_g, conv_out_g, w_out):
    b, s, _ = h.shape
    proj = h @ w_in
    q, k, v, c = jnp.split(proj, [ATTN_WIDTH, ATTN_WIDTH + KV_WIDTH, ATTN_WIDTH + 2 * KV_WIDTH], axis=-1)
    q = _rope(_rmsnorm(q.reshape(b, s, ATTN_HEADS, HEAD_DIM), q_norm_g), cos, sin)
    k = _rope(_rmsnorm(k.reshape(b, s, KV_HEADS, HEAD_DIM), k_norm_g), cos, sin)
    v = v.reshape(b, s, KV_HEADS, HEAD_DIM)
    attn = _gqa_blocked(q, k, v)
    val, gate = jnp.split(c, 2, axis=-1)
    u = val * jax.nn.sigmoid(gate)
    u = _depthwise_conv(u, conv_w, conv_b)
    u = jax.nn.silu(_layernorm(u, conv_ln_g, conv_ln_b))
    y = jnp.concatenate([_group_rms(attn, ATTN_HEADS, attn_out_g),
                         _group_rms(u, CONV_GROUPS, conv_out_g)], axis=-1)
    return y @ w_out


def _memory_attention(h, mem, w_mem_q, w_mem_kv, w_mem_o):
    b, s, _ = h.shape
    m = mem.shape[1]
    q = (h @ w_mem_q).reshape(b, s, MEM_HEADS, MEM_HEAD_DIM)
    k, v = jnp.split(mem @ w_mem_kv, 2, axis=-1)
    k = k.reshape(b, m, MEM_HEADS, MEM_HEAD_DIM)
    v = v.reshape(b, m, MEM_HEADS, MEM_HEAD_DIM)
    sc = jnp.einsum('bshd,bmhd->bhsm', q, k).astype(jnp.float32) * (MEM_HEAD_DIM ** -0.5)
    p = jax.nn.softmax(sc, axis=-1).astype(v.dtype)
    o = jnp.einsum('bhsm,bmhd->bshd', p, v).reshape(b, s, D_MODEL)
    return o @ w_mem_o


def _sq_relu_mlp(h, w_ff1, b_ff1, w_ff2, b_ff2):
    return jnp.square(jax.nn.relu(h @ w_ff1 + b_ff1)) @ w_ff2 + b_ff2


def setup_inputs(seed: int = 0) -> dict:
    key = jax.random.key(seed)
    ks = jax.random.split(key, 30)
    L, D = DEPTH, D_MODEL
    x = jax.random.normal(ks[0], (BATCH, SEQ, D), jnp.float32)
    mem = jax.random.normal(ks[1], (BATCH, N_MEM, D), jnp.float32)
    w_in = jnp.concatenate([_dense(ks[4], (L, D, ATTN_WIDTH + KV_WIDTH), D),
                            _dense(ks[5], (L, D, KV_WIDTH), D, BETA),
                            _dense(ks[6], (L, D, 2 * CONV_WIDTH), D)], axis=-1)
    w_mem_kv = jnp.concatenate([_dense(ks[19], (L, D, D), D),
                                _dense(ks[20], (L, D, D), D, BETA)], axis=-1)
    return {
        'x': x,
        'mem': mem,
        'ln_in_g': _gain(ks[2], (D,)),
        'ln_in_b': _bias(ks[3], (D,)),
        'w_in': w_in,
        'q_norm_g': _gain(ks[7], (L, HEAD_DIM)),
        'k_norm_g': _gain(ks[8], (L, HEAD_DIM)),
        'conv_w': _dense(ks[9], (L, CONV_K, CONV_WIDTH), CONV_K),
        'conv_b': _bias(ks[10], (L, CONV_WIDTH)),
        'conv_ln_g': _gain(ks[11], (L, CONV_WIDTH)),
        'conv_ln_b': _bias(ks[12], (L, CONV_WIDTH)),
        'attn_out_g': _gain(ks[13], (L, ATTN_WIDTH)),
        'conv_out_g': _gain(ks[14], (L, CONV_WIDTH)),
        'w_out': _dense(ks[15], (L, D, D), D, BETA),
        'ln1_g': _gain(ks[16], (L, D)),
        'ln1_b': _bias(ks[17], (L, D)),
        'w_mem_q': _dense(ks[18], (L, D, D), D),
        'w_mem_kv': w_mem_kv,
        'w_mem_o': _dense(ks[21], (L, D, D), D, BETA),
        'ln2_g': _gain(ks[22], (L, D)),
        'ln2_b': _bias(ks[23], (L, D)),
        'w_ff1': _dense(ks[24], (L, D, D_FF), D, BETA),
        'b_ff1': _bias(ks[25], (L, D_FF)),
        'w_ff2': _dense(ks[26], (L, D_FF, D), D_FF, BETA),
        'b_ff2': _bias(ks[27], (L, D)),
        'ln3_g': _gain(ks[28], (L, D)),
        'ln3_b': _bias(ks[29], (L, D)),
    }


def reference(x, mem, ln_in_g, ln_in_b, w_in, q_norm_g, k_norm_g, conv_w, conv_b, conv_ln_g, conv_ln_b,
              attn_out_g, conv_out_g, w_out, ln1_g, ln1_b, w_mem_q, w_mem_kv, w_mem_o, ln2_g, ln2_b,
              w_ff1, b_ff1, w_ff2, b_ff2, ln3_g, ln3_b):
    cos, sin = _axial_rotary(x.shape[1])
    h = _layernorm(x, ln_in_g, ln_in_b)
    for l in range(DEPTH):
        mix = _hybrid_mixer(h, cos, sin, w_in[l], q_norm_g[l], k_norm_g[l], conv_w[l], conv_b[l],
                            conv_ln_g[l], conv_ln_b[l], attn_out_g[l], conv_out_g[l], w_out[l])
        h = _layernorm(ALPHA * h + mix, ln1_g[l], ln1_b[l])
        h = _layernorm(ALPHA * h + _memory_attention(h, mem, w_mem_q[l], w_mem_kv[l], w_mem_o[l]),
                       ln2_g[l], ln2_b[l])
        h = _layernorm(ALPHA * h + _sq_relu_mlp(h, w_ff1[l], b_ff1[l], w_ff2[l], b_ff2[l]),
                       ln3_g[l], ln3_b[l])
    return h
```

```cpp
#include <hip/hip_runtime.h>
#include <hip/hip_cooperative_groups.h>
#include <cstdio>
#include <cstdint>
namespace cg = cooperative_groups;

#define LAS __attribute__((address_space(3)))
typedef unsigned short bf16_t;
typedef short bf16x8 __attribute__((ext_vector_type(8)));
typedef short s16x4 __attribute__((ext_vector_type(4)));
typedef float f32x4 __attribute__((ext_vector_type(4)));
typedef float f32x16 __attribute__((ext_vector_type(16)));
typedef unsigned u32x4 __attribute__((ext_vector_type(4)));
typedef unsigned u32x2 __attribute__((ext_vector_type(2)));

constexpr int NTHR = 512;
constexpr int BATCH = 8, SEQ = 2048, DM = 1024, MTOK = BATCH * SEQ, NMEM = 256, MMEM = BATCH * NMEM, DFF = 4096, INC = 1792;
constexpr float LN_EPS = 1e-5f;
constexpr float ALPHA = 1.189207115002721f;
constexpr int LDS_BYTES = 131072;

constexpr size_t MiB = 1024 * 1024;
constexpr size_t OFF_WIN = 0;
constexpr size_t OFF_WOUT = OFF_WIN + (size_t)INC * DM * 2;
constexpr size_t OFF_WMQ = OFF_WOUT + (size_t)DM * DM * 2;
constexpr size_t OFF_WMKV = OFF_WMQ + (size_t)DM * DM * 2;
constexpr size_t OFF_WMO = OFF_WMKV + (size_t)2 * DM * DM * 2;
constexpr size_t OFF_WFF1 = OFF_WMO + (size_t)DM * DM * 2;
constexpr size_t OFF_WFF2 = OFF_WFF1 + (size_t)DFF * DM * 2;
constexpr size_t OFF_A = OFF_WFF2 + (size_t)DFF * DM * 2;
constexpr size_t OFF_B = OFF_A + 64 * MiB;
constexpr size_t OFF_REST = OFF_B + 32 * MiB;
constexpr size_t OFF_MEMB = OFF_REST;
constexpr size_t OFF_MEMK = OFF_REST + 4 * MiB;
constexpr size_t OFF_MEMVT = OFF_REST + 8 * MiB;
constexpr size_t OFF_T = OFF_REST + 12 * MiB;
constexpr size_t OFF_Y = OFF_T + 64 * MiB;
constexpr size_t OFF_Q = OFF_Y + 32 * MiB;
constexpr size_t OFF_KR = OFF_Q + 16 * MiB;
constexpr size_t OFF_A1 = OFF_REST;
constexpr size_t OFF_SMALL = OFF_REST + 128 * MiB;
constexpr size_t WS_END = OFF_SMALL + 128 * 1024;
constexpr int SM_QG = 0, SM_KG = 64, SM_CONVW = 128, SM_CONVB = SM_CONVW + 31 * 512, SM_CLNG = SM_CONVB + 512, SM_CLNB = SM_CLNG + 512,
              SM_AOG = SM_CLNB + 512, SM_COG = SM_AOG + 512, SM_LN1G = SM_COG + 512, SM_LN1B = SM_LN1G + 1024, SM_LN2G = SM_LN1B + 1024,
              SM_LN2B = SM_LN2G + 1024, SM_BFF1 = SM_LN2B + 1024, SM_BFF2 = SM_BFF1 + 4096, SM_LN3G = SM_BFF2 + 1024, SM_LN3B = SM_LN3G + 1024,
              SM_END = SM_LN3B + 1024;
static_assert(SM_END * 4 <= 128 * 1024, "small block");

struct Params {
    const float* in[27];
    float* out;
    unsigned char* ws;
    int ph_lo, ph_hi;
};

__device__ __forceinline__ unsigned cvt_pk_bf16(float lo, float hi) { unsigned r; asm volatile("v_cvt_pk_bf16_f32 %0, %1, %2" : "=v"(r) : "v"(lo), "v"(hi)); return r; }
__device__ __forceinline__ float bf2f(unsigned short b) { return __uint_as_float(((unsigned)b) << 16); }
__device__ __forceinline__ float bflo(unsigned w) { return __uint_as_float(w << 16); }
__device__ __forceinline__ float bfhi(unsigned w) { return __uint_as_float(w & 0xffff0000u); }
__device__ __forceinline__ float wave_sum(float v) {
#pragma unroll
    for (int o = 32; o > 0; o >>= 1) v += __shfl_xor(v, o);
    return v;
}
__device__ __forceinline__ float wave_max(float v) {
#pragma unroll
    for (int o = 32; o > 0; o >>= 1) v = fmaxf(v, __shfl_xor(v, o));
    return v;
}
__device__ __forceinline__ int otid() { int t = threadIdx.x; asm volatile("" : "+v"(t)); return t; }
__device__ __forceinline__ int obid() { int t = blockIdx.x; asm volatile("" : "+s"(t)); return t; }
__device__ __forceinline__ int ogrid() { int t = gridDim.x; asm volatile("" : "+s"(t)); return t; }
__device__ __forceinline__ float sigmoidf_(float x) { return __builtin_amdgcn_rcpf(1.f + __expf(-x)); }

constexpr int BM = 256, BK = 64, HALF = 128, HTB = HALF * BK * 2, NXCD = 8, WGM = 8;

__device__ __forceinline__ int lds_byte(int r, int c) { const int st = (r >> 4) * 2 + (c >> 5), rr = r & 15, cc = c & 31, ob = rr * 64 + cc * 2; return st * 1024 + (ob ^ (((ob >> 9) & 1) << 5)); }
__device__ __forceinline__ void stage_rc(int b, int& R, int& C) { const int st = b / 1024, sb = b % 1024, swz = sb ^ (((sb >> 9) & 1) << 5); R = (st >> 1) * 16 + swz / 64; C = (st & 1) * 32 + (swz % 64) / 2; }
__device__ __forceinline__ int perm32(int rho) { const int n = rho >> 4, i = rho & 15; return 8 * (i >> 2) + 4 * n + (i & 3); }

struct GemmDesc {
    const bf16_t* A; const bf16_t* Bt; int lda, ldb, K;
    int nM, nN, nZ, zdiv;
    long sA0, sA1, sB0, sB1;
    int rz0, cz1;
    int shift;
    int kind;
    void* out; int ldc; const float* bias; float scale; int act; float alpha;
};
struct Unit { const char* a; const char* b; int row0, col0; };

__device__ __forceinline__ bool next_unit(const GemmDesc& d, int i, int G, int c, Unit& u) {
    const int per = d.nM * d.nN; const long L = (long)i * G + c;
    if (L >= (long)per * d.nZ) return false;
    const int z = (int)(L / per); int w = (int)(L % per); int pm, pn;
    if (d.nZ == 1) {
        const int nwg = per; const int q = nwg / NXCD, r = nwg % NXCD, xcd = w % NXCD, off = w / NXCD;
        w = (xcd < r ? xcd * (q + 1) : r * (q + 1) + (xcd - r) * q) + off;
        const int nig = WGM * d.nN, gid = w / nig, fm = gid * WGM, gsz = (d.nM - fm) < WGM ? (d.nM - fm) : WGM;
        pm = fm + ((w % nig) % gsz); pn = (w % nig) / gsz;
    } else { pm = w % d.nM; pn = w / d.nM; }
    const int z0 = z / d.zdiv, z1 = z % d.zdiv;
    u.a = (const char*)(d.A + (long)z0 * d.sA0 + (long)z1 * d.sA1 + (long)pm * BM * d.lda);
    u.b = (const char*)(d.Bt + (long)z0 * d.sB0 + (long)z1 * d.sB1 + (long)pn * BM * d.ldb);
    u.row0 = z0 * d.rz0 + pm * BM; u.col0 = z1 * d.cz1 + pn * BM;
    return true;
}

__device__ __forceinline__ void gemm_epilogue(const f32x4 (&acc)[2][2][4][2], const GemmDesc& d, const Unit& u, int wr, int wc, int fr, int fq) {
    const int row0 = u.row0 + wr * 64 + fr, col0 = u.col0 + wc * 32 + 8 * fq;
    f32x4 bv[2][2];
#pragma unroll
    for (int bj = 0; bj < 2; ++bj)
#pragma unroll
        for (int n = 0; n < 2; ++n) bv[bj][n] = d.bias ? *(const f32x4*)(d.bias + col0 + bj * HALF + 4 * n) : (f32x4){0.f, 0.f, 0.f, 0.f};
    const float sc = d.scale;
    if (d.kind == 0) {
        bf16_t* O = (bf16_t*)d.out;
#pragma unroll
        for (int ai = 0; ai < 2; ++ai)
#pragma unroll
            for (int m = 0; m < 4; ++m) {
                bf16_t* rowp = O + (size_t)(row0 + ai * HALF + m * 16) * d.ldc + col0;
#pragma unroll
                for (int bj = 0; bj < 2; ++bj) {
                    f32x4 v0 = acc[ai][bj][m][0] * sc + bv[bj][0], v1 = acc[ai][bj][m][1] * sc + bv[bj][1];
                    if (d.act == 1) {
#pragma unroll
                        for (int j = 0; j < 4; ++j) { float a = fmaxf(v0[j], 0.f), b = fmaxf(v1[j], 0.f); v0[j] = a * a; v1[j] = b * b; }
                    }
                    u32x4 w; w.x = cvt_pk_bf16(v0[0], v0[1]); w.y = cvt_pk_bf16(v0[2], v0[3]); w.z = cvt_pk_bf16(v1[0], v1[1]); w.w = cvt_pk_bf16(v1[2], v1[3]);
                    *(u32x4*)(rowp + bj * HALF) = w;
                }
            }
    } else {
        float* C = (float*)d.out; const float al = d.alpha;
#pragma unroll
        for (int ai = 0; ai < 2; ++ai)
#pragma unroll
            for (int m = 0; m < 4; ++m) {
                float* rowp = C + (size_t)(row0 + ai * HALF + m * 16) * d.ldc + col0;
#pragma unroll
                for (int bj = 0; bj < 2; ++bj) {
                    f32x4 v0 = acc[ai][bj][m][0] * sc + bv[bj][0], v1 = acc[ai][bj][m][1] * sc + bv[bj][1];
                    if (al != 0.f) { const f32x4 o0 = *(const f32x4*)(rowp + bj * HALF), o1 = *(const f32x4*)(rowp + bj * HALF + 4); v0 += o0 * al; v1 += o1 * al; }
                    *(f32x4*)(rowp + bj * HALF) = v0; *(f32x4*)(rowp + bj * HALF + 4) = v1;
                }
            }
    }
}

__device__ __forceinline__ void gemm_phase(LAS unsigned char* lds, const GemmDesc& d) {
    const int tid = otid(), wid = __builtin_amdgcn_readfirstlane(tid >> 6), lane = tid & 63, wr = wid >> 2, wc = wid & 3, fr = lane & 15, fq = lane >> 4;
    const int G = ogrid(); int cblk = obid() - d.shift; if (cblk < 0) cblk += G;
    const int K = d.K, nt = K / BK;
    unsigned voffA[2], voffB[2];
#pragma unroll
    for (int i = 0; i < 2; ++i) { int R, C; stage_rc(tid * 16 + i * 8192, R, C); const int Rb = (R & ~31) + perm32(R & 31);
        voffA[i] = (unsigned)(R * d.lda + C) * 2u; voffB[i] = (unsigned)(Rb * d.ldb + C) * 2u; }
    const size_t kstep = (size_t)(BK * 2);
    const size_t hstepA = (size_t)HALF * d.lda * 2, hstepB = (size_t)HALF * d.ldb * 2;
    const unsigned ldsw = (unsigned)wid * 1024u;
    const int aoff = lds_byte(wr * 64 + fr, fq * 8), boff = lds_byte(wc * 32 + fr, fq * 8);
#define PG8_SA(b, h) (((b) * 2 + (h)) * HTB)
#define PG8_SB(b, h) ((4 + (b) * 2 + (h)) * HTB)
#define PG8_STAGE(bufoff, gbase, voff) do { _Pragma("unroll") for (int _i = 0; _i < 2; ++_i) \
        __builtin_amdgcn_global_load_lds((const unsigned*)((const char*)(gbase) + (voff)[_i]), (LAS unsigned*)(lds + (bufoff) + ldsw + _i * 8192), 16, 0, 0); } while (0)
#define PG8_LDA(dst, b, h) do { _Pragma("unroll") for (int m = 0; m < 4; ++m) _Pragma("unroll") for (int k = 0; k < 2; ++k) dst[m][k] = *(const LAS bf16x8*)(lds + PG8_SA(b, h) + aoff + m * 2048 + k * 1024); } while (0)
#define PG8_LDB(dst, b, h) do { _Pragma("unroll") for (int n = 0; n < 2; ++n) _Pragma("unroll") for (int k = 0; k < 2; ++k) dst[n][k] = *(const LAS bf16x8*)(lds + PG8_SB(b, h) + boff + n * 2048 + k * 1024); } while (0)
#define PG8_MMA(ai, bj, At, Bt) do { __builtin_amdgcn_s_setprio(1); _Pragma("unroll") for (int m = 0; m < 4; ++m) _Pragma("unroll") for (int n = 0; n < 2; ++n) _Pragma("unroll") for (int k = 0; k < 2; ++k) \
        acc[ai][bj][m][n] = __builtin_amdgcn_mfma_f32_16x16x32_bf16(Bt[n][k], At[m][k], acc[ai][bj][m][n], 0, 0, 0); __builtin_amdgcn_s_setprio(0); } while (0)
#define PG8_WAIT_V(n) asm volatile("s_waitcnt vmcnt(" #n ")" ::: "memory")
#define PG8_WAIT_L(n) asm volatile("s_waitcnt lgkmcnt(" #n ")" ::: "memory")
#define PG8_BAR __builtin_amdgcn_s_barrier()
#define PG8_SCHED __builtin_amdgcn_sched_barrier(0)
    Unit cur, nxt; int ui = 0;
    if (!next_unit(d, 0, G, cblk, cur)) return;
    f32x4 acc[2][2][4][2];
#pragma unroll
    for (int a = 0; a < 2; ++a)
#pragma unroll
        for (int b = 0; b < 2; ++b)
#pragma unroll
            for (int m = 0; m < 4; ++m)
#pragma unroll
                for (int n = 0; n < 2; ++n) acc[a][b][m][n] = (f32x4){0.f, 0.f, 0.f, 0.f};
    bf16x8 At[4][2], B0[2][2], B1[2][2];
    const char* cA = cur.a; const char* cB = cur.b;
    PG8_STAGE(PG8_SB(0, 0), cB, voffB); PG8_STAGE(PG8_SA(0, 0), cA, voffA); PG8_STAGE(PG8_SB(0, 1), cB + hstepB, voffB); PG8_STAGE(PG8_SA(0, 1), cA + hstepA, voffA);
    if (wr == 1) PG8_BAR;
    PG8_WAIT_V(4); PG8_BAR;
    PG8_STAGE(PG8_SB(1, 0), cB + kstep, voffB); PG8_STAGE(PG8_SA(1, 0), cA + kstep, voffA); PG8_STAGE(PG8_SB(1, 1), cB + hstepB + kstep, voffB);
    PG8_WAIT_V(6); PG8_BAR;
    for (;;) {
        const bool has_next = next_unit(d, ui + 1, G, cblk, nxt);
        const char* nA = has_next ? nxt.a : cA; const char* nB = has_next ? nxt.b : cB;
        for (int t = 0; t < nt; t += 2) {
            const bool last = (t == nt - 2);
            const char* a1 = cA + (size_t)(t + 1) * kstep;
            const char* a2 = last ? nA : cA + (size_t)(t + 2) * kstep; const char* b2 = last ? nB : cB + (size_t)(t + 2) * kstep;
            const char* a3 = a2 + kstep; const char* b3 = b2 + kstep;
            PG8_LDB(B0, 0, 0); PG8_SCHED; PG8_LDA(At, 0, 0); PG8_STAGE(PG8_SA(1, 1), a1 + hstepA, voffA);
            PG8_WAIT_L(8); PG8_BAR; PG8_WAIT_L(0); PG8_MMA(0, 0, At, B0); PG8_BAR; PG8_SCHED;
            PG8_LDB(B1, 0, 1); PG8_STAGE(PG8_SB(0, 0), b2, voffB);
            PG8_BAR; PG8_WAIT_L(0); PG8_MMA(0, 1, At, B1); PG8_BAR;
            PG8_LDA(At, 0, 1); PG8_STAGE(PG8_SA(0, 0), a2, voffA);
            PG8_BAR; PG8_WAIT_L(0); PG8_MMA(1, 0, At, B0); PG8_BAR; PG8_SCHED;
            PG8_STAGE(PG8_SB(0, 1), b2 + hstepB, voffB);
            PG8_WAIT_V(6); PG8_BAR; PG8_MMA(1, 1, At, B1); PG8_BAR;
            PG8_LDB(B0, 1, 0); PG8_SCHED; PG8_LDA(At, 1, 0); PG8_STAGE(PG8_SA(0, 1), a2 + hstepA, voffA);
            PG8_WAIT_L(8); PG8_BAR; PG8_WAIT_L(0); PG8_MMA(0, 0, At, B0); PG8_BAR; PG8_SCHED;
            PG8_LDB(B1, 1, 1); PG8_STAGE(PG8_SB(1, 0), b3, voffB);
            PG8_BAR; PG8_WAIT_L(0); PG8_MMA(0, 1, At, B1); PG8_BAR;
            PG8_LDA(At, 1, 1); PG8_STAGE(PG8_SA(1, 0), a3, voffA);
            PG8_BAR; PG8_WAIT_L(0); PG8_MMA(1, 0, At, B0); PG8_BAR; PG8_SCHED;
            PG8_STAGE(PG8_SB(1, 1), b3 + hstepB, voffB);
            PG8_WAIT_V(6); PG8_BAR; PG8_MMA(1, 1, At, B1); PG8_BAR;
        }
        gemm_epilogue(acc, d, cur, wr, wc, fr, fq);
        if (!has_next) break;
#pragma unroll
        for (int a = 0; a < 2; ++a)
#pragma unroll
            for (int b = 0; b < 2; ++b)
#pragma unroll
                for (int m = 0; m < 4; ++m)
#pragma unroll
                    for (int n = 0; n < 2; ++n) acc[a][b][m][n] = (f32x4){0.f, 0.f, 0.f, 0.f};
        cur = nxt; cA = nA; cB = nB; ++ui;
    }
    PG8_WAIT_V(0);
    if (wr == 0) PG8_BAR;
    PG8_BAR;
#undef PG8_SA
#undef PG8_SB
#undef PG8_STAGE
#undef PG8_LDA
#undef PG8_LDB
#undef PG8_MMA
#undef PG8_WAIT_V
#undef PG8_WAIT_L
#undef PG8_BAR
#undef PG8_SCHED
}

namespace att {
constexpr int D = 64, NW = 8, QBLK = 32, KVBLK = 64;
constexpr float SCALE = 0.125f, THR = 8.f;
constexpr int SHM_V = KVBLK * D * 2, SHM_K = KVBLK * D * 2;
constexpr int LDQ = 512, LDK = 128, LDV = INC, LDY = DM;
#define KSWZ(row, colB) ((row) * 128 + ((colB) ^ ((((row) >> 1) & 7) << 4)))
#define SBAR() __builtin_amdgcn_sched_barrier(0)
__device__ __forceinline__ int crow(int r, int hi) { return (r & 3) + 8 * (r >> 2) + 4 * hi; }

__device__ __forceinline__ void partialSM(f32x16& p0, f32x16& p1, float& m_reg, float& mn, float& alpha) {
    constexpr float C = SCALE * 1.4426950408889634f;
    float pmax = p0[0];
#pragma unroll
    for (int r = 1; r < 16; ++r) pmax = fmaxf(pmax, p0[r]);
#pragma unroll
    for (int r = 0; r < 16; ++r) pmax = fmaxf(pmax, p1[r]);
    { auto rr = __builtin_amdgcn_permlane32_swap(__float_as_uint(pmax), __float_as_uint(pmax), false, false);
      pmax = fmaxf(__uint_as_float(rr[0]), __uint_as_float(rr[1])); }
    if (__builtin_expect(__all(pmax - m_reg <= THR / SCALE), 1)) { mn = m_reg; alpha = 1.f; }
    else { mn = fmaxf(m_reg, pmax); alpha = __builtin_amdgcn_exp2f((m_reg - mn) * C); m_reg = mn; }
    const float mnC = -mn * C;
#pragma unroll
    for (int r = 0; r < 16; ++r) p0[r] = fmaf(p0[r], C, mnC);
#pragma unroll
    for (int r = 0; r < 16; ++r) p1[r] = fmaf(p1[r], C, mnC);
#pragma unroll
    for (int r = 0; r < 16; ++r) p0[r] = __builtin_amdgcn_exp2f(p0[r]);
}
__device__ __forceinline__ void finishSM(f32x16& p0, f32x16& p1, float alpha, float& l_reg, bf16x8& pa0, bf16x8& pa1, bf16x8& pa2, bf16x8& pa3) {
#pragma unroll
    for (int r = 0; r < 16; ++r) p1[r] = __builtin_amdgcn_exp2f(p1[r]);
    float ps = 0;
#pragma unroll
    for (int r = 0; r < 16; ++r) ps += p0[r];
#pragma unroll
    for (int r = 0; r < 16; ++r) ps += p1[r];
    { auto rr = __builtin_amdgcn_permlane32_swap(__float_as_uint(ps), __float_as_uint(ps), false, false);
      ps = __uint_as_float(rr[0]) + __uint_as_float(rr[1]); }
    l_reg = l_reg * alpha + ps;
#define PK4(P, BASE, OUT) do { unsigned a0 = cvt_pk_bf16(P[BASE + 0], P[BASE + 1]), a1 = cvt_pk_bf16(P[BASE + 2], P[BASE + 3]);   \
    unsigned b0 = cvt_pk_bf16(P[BASE + 4], P[BASE + 5]), b1 = cvt_pk_bf16(P[BASE + 6], P[BASE + 7]);                              \
    auto r0 = __builtin_amdgcn_permlane32_swap(a0, b0, false, false); auto r1 = __builtin_amdgcn_permlane32_swap(a1, b1, false, false); \
    u32x4 w = {r0[0], r1[0], r0[1], r1[1]}; OUT = *reinterpret_cast<bf16x8*>(&w); } while (0)
    PK4(p0, 0, pa0); PK4(p0, 8, pa1); PK4(p1, 0, pa2); PK4(p1, 8, pa3);
#undef PK4
}
__device__ __forceinline__ void qkt(f32x16& p0, f32x16& p1, const char* Ks, const bf16x8* qr, int r32, int hi) {
    p0 = f32x16{}; p1 = f32x16{};
#pragma unroll
    for (int d0 = 0; d0 < 4; ++d0) { const int cb = (d0 * 16 + hi * 8) * 2;
        bf16x8 b0 = *reinterpret_cast<const bf16x8*>(Ks + KSWZ(r32, cb));
        bf16x8 b1 = *reinterpret_cast<const bf16x8*>(Ks + KSWZ(32 + r32, cb));
        p0 = __builtin_amdgcn_mfma_f32_32x32x16_bf16(b0, qr[d0], p0, 0, 0, 0);
        p1 = __builtin_amdgcn_mfma_f32_32x32x16_bf16(b1, qr[d0], p1, 0, 0, 0); }
}
__device__ __forceinline__ int v_st(int k, int c) { const int kk = (k & ~0xC) | ((k & 4) << 1) | ((k & 8) >> 1); return ((kk >> 3) * 2 + (c >> 5)) * 512 + ((kk & 7) * 32 + (c & 31)) * 2; }
__device__ __forceinline__ int v_rd_base(int lane) { return ((lane & 3) << 3) | (((lane >> 2) & 3) << 6) | (((lane >> 4) & 1) << 5) | (((lane >> 5) & 1) << 8); }
constexpr int v_rd_off(int d0, int ks, int half) { return d0 * 512 + ks * 2048 + half * 1024; }
template <int OFF> __device__ __forceinline__ s16x4 tr_read(int vb) {
    s16x4 r; asm volatile("ds_read_b64_tr_b16 %0, %1 offset:%2" : "=&v"(r) : "v"(vb), "i"(OFF) : "memory"); return r;
}
template <int D0> __device__ __forceinline__ void pv_one(f32x16& od, int vb, bf16x8 pa0, bf16x8 pa1, bf16x8 pa2, bf16x8 pa3) {
    const s16x4 l0 = tr_read<v_rd_off(D0, 0, 0)>(vb), h0 = tr_read<v_rd_off(D0, 0, 1)>(vb), l1 = tr_read<v_rd_off(D0, 1, 0)>(vb), h1 = tr_read<v_rd_off(D0, 1, 1)>(vb);
    const s16x4 l2 = tr_read<v_rd_off(D0, 2, 0)>(vb), h2 = tr_read<v_rd_off(D0, 2, 1)>(vb), l3 = tr_read<v_rd_off(D0, 3, 0)>(vb), h3 = tr_read<v_rd_off(D0, 3, 1)>(vb);
    asm volatile("s_waitcnt lgkmcnt(0)" ::: "memory"); SBAR();
#define PK(L, H) (bf16x8){L[0], L[1], L[2], L[3], H[0], H[1], H[2], H[3]}
    od = __builtin_amdgcn_mfma_f32_32x32x16_bf16(pa0, PK(l0, h0), od, 0, 0, 0);
    od = __builtin_amdgcn_mfma_f32_32x32x16_bf16(pa1, PK(l1, h1), od, 0, 0, 0);
    od = __builtin_amdgcn_mfma_f32_32x32x16_bf16(pa2, PK(l2, h2), od, 0, 0, 0);
    od = __builtin_amdgcn_mfma_f32_32x32x16_bf16(pa3, PK(l3, h3), od, 0, 0, 0);
#undef PK
}
__device__ __forceinline__ void pv_d0(f32x16* o, int vb, bf16x8 pa0, bf16x8 pa1, bf16x8 pa2, bf16x8 pa3) {
    pv_one<0>(o[0], vb, pa0, pa1, pa2, pa3); pv_one<1>(o[1], vb, pa0, pa1, pa2, pa3);
}

__device__ __forceinline__ void attn_body(const bf16_t* __restrict__ Qb, const bf16_t* __restrict__ Kh, const bf16_t* __restrict__ Vh,
                                          bf16_t* __restrict__ Yb, const float* __restrict__ gain, int seq, char* lds) {
    const int tid = otid(), wid = tid >> 6, lane = tid & 63, r32 = lane & 31, hi = lane >> 5;
    char* V_lds = lds; char* K_lds = lds + 2 * SHM_V;
    float* ws = (float*)(lds + 2 * SHM_V + 2 * SHM_K) + wid * 64; float* li_l = ws; float* al_l = ws + 32;
    float m_reg = -1e30f, l_reg = 0; f32x16 o[2] = {}; bf16x8 qr[4];
    const bf16_t* Qw = Qb + (long)(wid * QBLK + r32) * LDQ + hi * 8;
#pragma unroll
    for (int d0 = 0; d0 < 4; ++d0) qr[d0] = *reinterpret_cast<const bf16x8*>(Qw + d0 * 16);
    const int sr = tid >> 3, sc = (tid & 7) * 8, vst0 = v_st(sr, sc), kst0 = KSWZ(sr, sc * 2);
    const int vb0 = (int)(uintptr_t)V_lds + v_rd_base(lane);
    bf16x8 vsE, ksE, vsO, ksO;
#define SLOADE(k0) do { vsE = *reinterpret_cast<const bf16x8*>(&Vh[(long)((k0) + sr) * LDV + sc]); ksE = *reinterpret_cast<const bf16x8*>(&Kh[(long)((k0) + sr) * LDK + sc]); } while (0)
#define SLOADO(k0) do { vsO = *reinterpret_cast<const bf16x8*>(&Vh[(long)((k0) + sr) * LDV + sc]); ksO = *reinterpret_cast<const bf16x8*>(&Kh[(long)((k0) + sr) * LDK + sc]); } while (0)
#define SWRITEE(b) do { *(bf16x8*)(V_lds + (b) * SHM_V + vst0) = vsE; *(bf16x8*)(K_lds + (b) * SHM_K + kst0) = ksE; } while (0)
#define SWRITEO(b) do { *(bf16x8*)(V_lds + (b) * SHM_V + vst0) = vsO; *(bf16x8*)(K_lds + (b) * SHM_K + kst0) = ksO; } while (0)
#define SWAIT() asm volatile("s_waitcnt vmcnt(2)" ::: "memory")
#define RESC(a) do { if (__any((a) < 1.f)) { if (hi == 0) al_l[r32] = (a); asm volatile("s_waitcnt lgkmcnt(0)" ::: "memory"); \
    _Pragma("unroll") for (int dd = 0; dd < 2; ++dd) _Pragma("unroll") for (int r = 0; r < 16; ++r) o[dd][r] *= al_l[crow(r, hi)]; } } while (0)
    f32x16 pA0, pA1, pB0, pB1; float mnA, mnB, alA, alB; bf16x8 pa0, pa1, pa2, pa3; const int NTL = seq / KVBLK;
    SLOADE(0); asm volatile("s_waitcnt vmcnt(0)" ::: "memory"); SWRITEE(0); __syncthreads();
    qkt(pA0, pA1, K_lds, qr, r32, hi); partialSM(pA0, pA1, m_reg, mnA, alA);
    SLOADO(KVBLK); if (2 < NTL) SLOADE(2 * KVBLK);
    SWAIT(); SWRITEO(1); __syncthreads();
    for (int j = 1; j + 1 < NTL; j += 2) {
        SBAR(); qkt(pB0, pB1, K_lds + SHM_K, qr, r32, hi);
        finishSM(pA0, pA1, alA, l_reg, pa0, pa1, pa2, pa3); SBAR();
        SLOADO((j + 2) * KVBLK); SBAR();
        pv_d0(o, vb0, pa0, pa1, pa2, pa3); partialSM(pB0, pB1, m_reg, mnB, alB);
        __syncthreads(); SWAIT(); SWRITEE(0);
        RESC(alB); __syncthreads();
        SBAR(); qkt(pA0, pA1, K_lds, qr, r32, hi);
        finishSM(pB0, pB1, alB, l_reg, pa0, pa1, pa2, pa3); SBAR();
        if (j + 3 < NTL) SLOADE((j + 3) * KVBLK); SBAR();
        pv_d0(o, vb0 + SHM_V, pa0, pa1, pa2, pa3); partialSM(pA0, pA1, m_reg, mnA, alA);
        __syncthreads(); SWAIT(); SWRITEO(1);
        RESC(alA); __syncthreads();
    }
    SBAR(); qkt(pB0, pB1, K_lds + SHM_K, qr, r32, hi);
    finishSM(pA0, pA1, alA, l_reg, pa0, pa1, pa2, pa3); SBAR();
    pv_d0(o, vb0, pa0, pa1, pa2, pa3); partialSM(pB0, pB1, m_reg, mnB, alB);
    __syncthreads(); RESC(alB);
    finishSM(pB0, pB1, alB, l_reg, pa0, pa1, pa2, pa3); SBAR();
    pv_d0(o, vb0 + SHM_V, pa0, pa1, pa2, pa3);
    if (hi == 0) li_l[r32] = l_reg; asm volatile("s_waitcnt lgkmcnt(0)" ::: "memory");
    const float g0 = gain[r32], g1 = gain[32 + r32];
    bf16_t* Yw = Yb + (long)(wid * QBLK) * LDY;
#pragma unroll
    for (int r = 0; r < 16; ++r) {
        const int orow = crow(r, hi);
        const float rl = __builtin_amdgcn_rcpf(li_l[orow]);
        const float a = o[0][r] * rl, b = o[1][r] * rl;
        float ss = a * a + b * b;
        ss += __shfl_xor(ss, 1); ss += __shfl_xor(ss, 2); ss += __shfl_xor(ss, 4); ss += __shfl_xor(ss, 8); ss += __shfl_xor(ss, 16);
        const float rs = rsqrtf(ss * (1.f / 64.f) + LN_EPS);
        const unsigned wa = cvt_pk_bf16(a * rs * g0, b * rs * g1);
        Yw[(long)orow * LDY + r32] = (bf16_t)(wa & 0xffffu);
        Yw[(long)orow * LDY + 32 + r32] = (bf16_t)(wa >> 16);
    }
    __syncthreads();
#undef SLOADE
#undef SLOADO
#undef SWRITEE
#undef SWRITEO
#undef SWAIT
#undef RESC
}
}

__device__ __forceinline__ void ln_rows(const float* src, float* dstf, bf16_t* dstb, const float* __restrict__ g, const float* __restrict__ b) {
    const int tid = otid(), lane = tid & 63, wid = tid >> 6;
    const int nw = ogrid() * 8;
    f32x4 gv[4], bv[4];
#pragma unroll
    for (int j = 0; j < 4; ++j) { gv[j] = *(const f32x4*)(g + j * 256 + lane * 4); bv[j] = *(const f32x4*)(b + j * 256 + lane * 4); }
    for (int row = obid() * 8 + wid; row < MTOK; row += nw) {
        const float* sp = src + (size_t)row * DM;
        f32x4 v[4];
#pragma unroll
        for (int j = 0; j < 4; ++j) v[j] = *(const f32x4*)(sp + j * 256 + lane * 4);
        float s = 0.f;
#pragma unroll
        for (int j = 0; j < 4; ++j) s += v[j][0] + v[j][1] + v[j][2] + v[j][3];
        const float mean = wave_sum(s) * (1.f / DM);
        float q = 0.f;
#pragma unroll
        for (int j = 0; j < 4; ++j) { v[j] -= mean; q += v[j][0] * v[j][0] + v[j][1] * v[j][1] + v[j][2] * v[j][2] + v[j][3] * v[j][3]; }
        const float rstd = rsqrtf(wave_sum(q) * (1.f / DM) + LN_EPS);
#pragma unroll
        for (int j = 0; j < 4; ++j) {
            const f32x4 y = v[j] * rstd * gv[j] + bv[j];
            if (dstf) *(f32x4*)(dstf + (size_t)row * DM + j * 256 + lane * 4) = y;
            if (dstb) { u32x2 w; w.x = cvt_pk_bf16(y[0], y[1]); w.y = cvt_pk_bf16(y[2], y[3]); *(u32x2*)(dstb + (size_t)row * DM + j * 256 + lane * 4) = w; }
        }
    }
}

__device__ __forceinline__ void transpose_tile(const float* __restrict__ W, bf16_t* __restrict__ Wt, int K, int N, int tile, float* tl) {
    const int tn = N >> 6; const int k0 = (tile / tn) * 64, n0 = (tile % tn) * 64; const int tid = otid();
#pragma unroll
    for (int i = 0; i < 8; ++i) { const int idx = tid + i * NTHR, kk = idx >> 6, nn = idx & 63; tl[kk * 65 + nn] = W[(size_t)(k0 + kk) * N + n0 + nn]; }
    __syncthreads();
    { const int nn = tid >> 3, kc = (tid & 7) * 8; float v[8];
#pragma unroll
      for (int j = 0; j < 8; ++j) v[j] = tl[(kc + j) * 65 + nn];
      u32x4 w; w.x = cvt_pk_bf16(v[0], v[1]); w.y = cvt_pk_bf16(v[2], v[3]); w.z = cvt_pk_bf16(v[4], v[5]); w.w = cvt_pk_bf16(v[6], v[7]);
      *(u32x4*)(Wt + (size_t)(n0 + nn) * K + k0 + kc) = w; }
    __syncthreads();
}

__device__ __forceinline__ void phase_prep(const Params& p, char* lds) {
    unsigned char* ws = p.ws; float* tl = (float*)lds;
    constexpr int T0 = 448, T1 = T0 + 256, T2 = T1 + 256, T3 = T2 + 512, T4 = T3 + 256, T5 = T4 + 1024, T6 = T5 + 1024;
    for (int t = blockIdx.x; t < T6; t += gridDim.x) {
        if (t < T0) transpose_tile(p.in[4], (bf16_t*)(ws + OFF_WIN), DM, INC, t, tl);
        else if (t < T1) transpose_tile(p.in[13], (bf16_t*)(ws + OFF_WOUT), DM, DM, t - T0, tl);
        else if (t < T2) transpose_tile(p.in[16], (bf16_t*)(ws + OFF_WMQ), DM, DM, t - T1, tl);
        else if (t < T3) transpose_tile(p.in[17], (bf16_t*)(ws + OFF_WMKV), DM, 2 * DM, t - T2, tl);
        else if (t < T4) transpose_tile(p.in[18], (bf16_t*)(ws + OFF_WMO), DM, DM, t - T3, tl);
        else if (t < T5) transpose_tile(p.in[21], (bf16_t*)(ws + OFF_WFF1), DM, DFF, t - T4, tl);
        else transpose_tile(p.in[23], (bf16_t*)(ws + OFF_WFF2), DFF, DM, t - T5, tl);
    }
    { float* sm = (float*)(ws + OFF_SMALL); const int gt = blockIdx.x * NTHR + threadIdx.x, gs = gridDim.x * NTHR;
#define CPY(idx, off, n) for (int i = gt; i < (n); i += gs) sm[(off) + i] = p.in[idx][i];
      CPY(5, SM_QG, 64) CPY(6, SM_KG, 64) CPY(7, SM_CONVW, 31 * 512) CPY(8, SM_CONVB, 512) CPY(9, SM_CLNG, 512) CPY(10, SM_CLNB, 512)
      CPY(11, SM_AOG, 512) CPY(12, SM_COG, 512) CPY(14, SM_LN1G, 1024) CPY(15, SM_LN1B, 1024) CPY(19, SM_LN2G, 1024) CPY(20, SM_LN2B, 1024)
      CPY(22, SM_BFF1, 4096) CPY(24, SM_BFF2, 1024) CPY(25, SM_LN3G, 1024) CPY(26, SM_LN3B, 1024)
#undef CPY
    }
    ln_rows(p.in[0], (float*)(ws + OFF_A), (bf16_t*)(ws + OFF_B), p.in[2], p.in[3]);
    { const float* mem = p.in[1]; bf16_t* mb = (bf16_t*)(ws + OFF_MEMB);
      for (size_t i = ((size_t)blockIdx.x * NTHR + threadIdx.x) * 8; i < (size_t)MMEM * DM; i += (size_t)gridDim.x * NTHR * 8) {
          const f32x4 a = *(const f32x4*)(mem + i), b = *(const f32x4*)(mem + i + 4);
          u32x4 w; w.x = cvt_pk_bf16(a[0], a[1]); w.y = cvt_pk_bf16(a[2], a[3]); w.z = cvt_pk_bf16(b[0], b[1]); w.w = cvt_pk_bf16(b[2], b[3]);
          *(u32x4*)(mb + i) = w; } }
}

__device__ __forceinline__ void phase_qk(const Params& p) {
    const bf16_t* proj = (const bf16_t*)(p.ws + OFF_T);
    bf16_t* qR = (bf16_t*)(p.ws + OFF_Q); bf16_t* kR = (bf16_t*)(p.ws + OFF_KR);
    const float* sm = (const float*)(p.ws + OFF_SMALL); const float* qg = sm + SM_QG; const float* kg = sm + SM_KG;
    const long total = (long)MTOK * 80;
    for (long g = (long)obid() * NTHR + otid(); g < total; g += (long)ogrid() * NTHR) {
        const int tok = (int)(g / 80), ch = (int)(g % 80), head = ch >> 3, part = ch & 7;
        const int col = (head < 8) ? head * 64 : 512 + (head - 8) * 64;
        const u32x4 raw = *(const u32x4*)(proj + (size_t)tok * INC + col + part * 8);
        float x[8]; x[0] = bflo(raw.x); x[1] = bfhi(raw.x); x[2] = bflo(raw.y); x[3] = bfhi(raw.y); x[4] = bflo(raw.z); x[5] = bfhi(raw.z); x[6] = bflo(raw.w); x[7] = bfhi(raw.w);
        float ss = 0.f;
#pragma unroll
        for (int j = 0; j < 8; ++j) ss += x[j] * x[j];
        ss += __shfl_xor(ss, 1); ss += __shfl_xor(ss, 2); ss += __shfl_xor(ss, 4);
        const float rs = rsqrtf(ss * (1.f / 64.f) + LN_EPS);
        const float* gp = (head < 8 ? qg : kg) + part * 8;
        const f32x4 ga = *(const f32x4*)gp, gb = *(const f32x4*)(gp + 4);
        x[0] *= rs * ga[0]; x[1] *= rs * ga[1]; x[2] *= rs * ga[2]; x[3] *= rs * ga[3];
        x[4] *= rs * gb[0]; x[5] *= rs * gb[1]; x[6] *= rs * gb[2]; x[7] *= rs * gb[3];
        const int s = tok & (SEQ - 1);
        const float pos = (float)((part < 4) ? (s >> 6) : (s & 63));
        float y[8];
#pragma unroll
        for (int jj = 0; jj < 4; ++jj) {
            const int fi = (part & 3) * 4 + jj;
            const float inv = exp2f(-(float)fi * (13.287712379549449f / 16.f));
            const float ang = pos * inv;
            float sn, cs; __sincosf(ang, &sn, &cs);
            y[2 * jj] = x[2 * jj] * cs - x[2 * jj + 1] * sn;
            y[2 * jj + 1] = x[2 * jj] * sn + x[2 * jj + 1] * cs;
        }
        u32x4 w; w.x = cvt_pk_bf16(y[0], y[1]); w.y = cvt_pk_bf16(y[2], y[3]); w.z = cvt_pk_bf16(y[4], y[5]); w.w = cvt_pk_bf16(y[6], y[7]);
        if (head < 8) *(u32x4*)(qR + (size_t)tok * 512 + head * 64 + part * 8) = w;
        else *(u32x4*)(kR + (size_t)tok * 128 + (head - 8) * 64 + part * 8) = w;
    }
}

constexpr int CT = 16, CROWS = CT + 30;
__device__ __forceinline__ void phase_conv(const Params& p, char* lds) {
    const bf16_t* proj = (const bf16_t*)(p.ws + OFF_T);
    bf16_t* Y = (bf16_t*)(p.ws + OFF_Y);
    const float* sm = (const float*)(p.ws + OFF_SMALL);
    float* U = (float*)lds;
    float* red = (float*)(lds + CROWS * 512 * 4);
    const int tid = otid(), c = tid, lane = tid & 63, wid = tid >> 6;
    float w[31];
#pragma unroll
    for (int j = 0; j < 31; ++j) w[j] = sm[SM_CONVW + j * 512 + c];
    const float cb = sm[SM_CONVB + c], lg = sm[SM_CLNG + c], lb = sm[SM_CLNB + c], og = sm[SM_COG + c];
    for (int tile = obid(); tile < MTOK / CT; tile += ogrid()) {
        const int tok0 = tile * CT, bb = tok0 / SEQ, s0 = tok0 % SEQ;
        for (int q = tid; q < CROWS * 64; q += NTHR) {
            const int r = q >> 6, c8 = (q & 63) * 8; const int s = s0 - 15 + r;
            f32x4 u0 = {0.f, 0.f, 0.f, 0.f}, u1 = {0.f, 0.f, 0.f, 0.f};
            if (s >= 0 && s < SEQ) {
                const bf16_t* rp = proj + (size_t)(bb * SEQ + s) * INC;
                const u32x4 vv = *(const u32x4*)(rp + 768 + c8), gg = *(const u32x4*)(rp + 1280 + c8);
                u0[0] = bflo(vv.x) * sigmoidf_(bflo(gg.x)); u0[1] = bfhi(vv.x) * sigmoidf_(bfhi(gg.x));
                u0[2] = bflo(vv.y) * sigmoidf_(bflo(gg.y)); u0[3] = bfhi(vv.y) * sigmoidf_(bfhi(gg.y));
                u1[0] = bflo(vv.z) * sigmoidf_(bflo(gg.z)); u1[1] = bfhi(vv.z) * sigmoidf_(bfhi(gg.z));
                u1[2] = bflo(vv.w) * sigmoidf_(bflo(gg.w)); u1[3] = bfhi(vv.w) * sigmoidf_(bfhi(gg.w));
            }
            *(f32x4*)(U + r * 512 + c8) = u0; *(f32x4*)(U + r * 512 + c8 + 4) = u1;
        }
        __syncthreads();
        float acc[CT];
#pragma unroll
        for (int t = 0; t < CT; ++t) acc[t] = cb;
#pragma unroll
        for (int r = 0; r < CROWS; ++r) {
            const float uv = U[r * 512 + c];
#pragma unroll
            for (int t = 0; t < CT; ++t) { const int j = r - t; if (j >= 0 && j <= 30) acc[t] = fmaf(uv, w[j], acc[t]); }
        }
#pragma unroll
        for (int t = 0; t < CT; ++t) {
            const float s1 = wave_sum(acc[t]), s2 = wave_sum(acc[t] * acc[t]);
            if (lane == 0) { red[(wid * CT + t) * 2] = s1; red[(wid * CT + t) * 2 + 1] = s2; }
        }
        __syncthreads();
#pragma unroll
        for (int t = 0; t < CT; ++t) {
            float s1 = 0.f, s2 = 0.f;
#pragma unroll
            for (int ww = 0; ww < 8; ++ww) { s1 += red[(ww * CT + t) * 2]; s2 += red[(ww * CT + t) * 2 + 1]; }
            const float mean = s1 * (1.f / 512.f); const float var = fmaxf(s2 * (1.f / 512.f) - mean * mean, 0.f);
            const float yv = (acc[t] - mean) * rsqrtf(var + LN_EPS) * lg + lb;
            const float sv = yv * sigmoidf_(yv);
            const float gs = wave_sum(sv * sv);
            const float ov = sv * rsqrtf(gs * (1.f / 64.f) + LN_EPS) * og;
            const unsigned pk = cvt_pk_bf16(ov, 0.f);
            Y[(size_t)(tok0 + t) * DM + 512 + c] = (bf16_t)(pk & 0xffffu);
        }
        __syncthreads();
    }
}

__device__ __forceinline__ void phase_attn(const Params& p, char* lds) {
    const bf16_t* proj = (const bf16_t*)(p.ws + OFF_T);
    const bf16_t* qR = (const bf16_t*)(p.ws + OFF_Q); const bf16_t* kR = (const bf16_t*)(p.ws + OFF_KR);
    bf16_t* Y = (bf16_t*)(p.ws + OFF_Y);
    for (int item = obid(); item < BATCH * 8 * (SEQ / 256); item += ogrid()) {
        const int qb = item & 7, h = (item >> 3) & 7, b = item >> 6, kvh = h >> 2;
        const size_t tok0 = (size_t)b * SEQ;
        att::attn_body(qR + (tok0 + qb * 256) * 512 + h * 64, kR + tok0 * 128 + kvh * 64, proj + tok0 * INC + 640 + kvh * 64,
                       Y + (tok0 + qb * 256) * DM + h * 64, (const float*)(p.ws + OFF_SMALL) + SM_AOG + h * 64, SEQ, lds);
    }
}

__device__ __forceinline__ void phase_softmax(const Params& p) {
    const float* Sc = (const float*)(p.ws + OFF_T); bf16_t* P = (bf16_t*)(p.ws + OFF_Y);
    const int tid = otid(), lane = tid & 63, wid = tid >> 6; const int nw = ogrid() * 8;
    for (int row = obid() * 8 + wid; row < MTOK; row += nw) {
#pragma unroll
        for (int h = 0; h < 4; ++h) {
            const f32x4 v = *(const f32x4*)(Sc + (size_t)row * DM + h * 256 + lane * 4);
            const float mx = wave_max(fmaxf(fmaxf(v[0], v[1]), fmaxf(v[2], v[3])));
            const float e0 = __expf(v[0] - mx), e1 = __expf(v[1] - mx), e2 = __expf(v[2] - mx), e3 = __expf(v[3] - mx);
            const float inv = 1.f / wave_sum(e0 + e1 + e2 + e3);
            u32x2 w; w.x = cvt_pk_bf16(e0 * inv, e1 * inv); w.y = cvt_pk_bf16(e2 * inv, e3 * inv);
            *(u32x2*)(P + (size_t)row * DM + h * 256 + lane * 4) = w;
        }
    }
}

__device__ __forceinline__ GemmDesc plain_gemm(const bf16_t* A, int lda, const bf16_t* Bt, int ldb, int M, int N, int K, int shift,
                                               int kind, void* out, int ldc, const float* bias, float scale, int act, float alpha) {
    GemmDesc d; d.A = A; d.Bt = Bt; d.lda = lda; d.ldb = ldb; d.K = K; d.nM = M / BM; d.nN = N / BM; d.nZ = 1; d.zdiv = 1;
    d.sA0 = d.sA1 = d.sB0 = d.sB1 = 0; d.rz0 = 0; d.cz1 = 0; d.shift = shift; d.kind = kind; d.out = out; d.ldc = ldc; d.bias = bias; d.scale = scale; d.act = act; d.alpha = alpha;
    return d;
}

enum { PH_PREP = 0, PH_G1, PH_QKCONV, PH_ATTN, PH_G2, PH_LN1, PH_G3, PH_G4, PH_SOFTMAX, PH_G5, PH_G6, PH_LN2, PH_G7, PH_G8, PH_LN3, PH_COUNT };

__device__ __forceinline__ int gemm_count(int ph) {
    switch (ph) { case PH_G1: return 3; case PH_G2: case PH_G3: case PH_G4: case PH_G5: case PH_G6: case PH_G7: case PH_G8: return 1; default: return 0; }
}
__device__ __forceinline__ GemmDesc make_desc(const Params& p, int ph, int gi) {
    unsigned char* ws = p.ws;
    const bf16_t* Bh = (const bf16_t*)(ws + OFF_B);
    switch (ph) {
    case PH_G1:
        if (gi == 0) return plain_gemm(Bh, DM, (const bf16_t*)(ws + OFF_WIN), DM, MTOK, INC, DM, 0, 0, ws + OFF_T, INC, nullptr, 1.f, 0, 0.f);
        if (gi == 1) return plain_gemm((const bf16_t*)(ws + OFF_MEMB), DM, (const bf16_t*)(ws + OFF_WMKV), DM, MMEM, DM, DM, 192, 0, ws + OFF_MEMK, DM, nullptr, 1.f, 0, 0.f);
        return plain_gemm((const bf16_t*)(ws + OFF_WMKV) + (size_t)DM * DM, DM, (const bf16_t*)(ws + OFF_MEMB), DM, DM, MMEM, DM, 224, 0, ws + OFF_MEMVT, MMEM, nullptr, 1.f, 0, 0.f);
    case PH_G2:
        return plain_gemm((const bf16_t*)(ws + OFF_Y), DM, (const bf16_t*)(ws + OFF_WOUT), DM, MTOK, DM, DM, 0, 1, ws + OFF_A, DM, nullptr, 1.f, 0, ALPHA);
    case PH_G3:
        return plain_gemm(Bh, DM, (const bf16_t*)(ws + OFF_WMQ), DM, MTOK, DM, DM, 0, 0, ws + OFF_Y, DM, nullptr, 1.f, 0, 0.f);
    case PH_G4: {
        GemmDesc d = plain_gemm((const bf16_t*)(ws + OFF_Y), DM, (const bf16_t*)(ws + OFF_MEMK), DM, SEQ, NMEM, 256, 0, 1, ws + OFF_T, DM, nullptr, 0.0625f, 0, 0.f);
        d.nZ = BATCH * 4; d.zdiv = 4; d.sA0 = (long)SEQ * DM; d.sA1 = 256; d.sB0 = (long)NMEM * DM; d.sB1 = 256; d.rz0 = SEQ; d.cz1 = 256; return d; }
    case PH_G5: {
        GemmDesc d = plain_gemm((const bf16_t*)(ws + OFF_Y), DM, (const bf16_t*)(ws + OFF_MEMVT), MMEM, SEQ, 256, 256, 0, 0, ws + OFF_T, DM, nullptr, 1.f, 0, 0.f);
        d.nZ = BATCH * 4; d.zdiv = 4; d.sA0 = (long)SEQ * DM; d.sA1 = 256; d.sB0 = NMEM; d.sB1 = (long)256 * MMEM; d.rz0 = SEQ; d.cz1 = 256; return d; }
    case PH_G6:
        return plain_gemm((const bf16_t*)(ws + OFF_T), DM, (const bf16_t*)(ws + OFF_WMO), DM, MTOK, DM, DM, 0, 1, ws + OFF_A, DM, nullptr, 1.f, 0, ALPHA);
    case PH_G7:
        return plain_gemm(Bh, DM, (const bf16_t*)(ws + OFF_WFF1), DM, MTOK, DFF, DM, 0, 0, ws + OFF_A1, DFF, (const float*)(ws + OFF_SMALL) + SM_BFF1, 1.f, 1, 0.f);
    default:
        return plain_gemm((const bf16_t*)(ws + OFF_A1), DFF, (const bf16_t*)(ws + OFF_WFF2), DFF, MTOK, DM, DFF, 0, 1, ws + OFF_A, DM, (const float*)(ws + OFF_SMALL) + SM_BFF2, 1.f, 0, ALPHA);
    }
}

__global__ void __launch_bounds__(NTHR) mega(Params p) {
    extern __shared__ __attribute__((aligned(16))) unsigned char lds_raw[];
    cg::grid_group grid = cg::this_grid();
    unsigned char* ws = p.ws;
    int ph0 = p.ph_lo;
    if (ph0 == PH_PREP) {
        phase_prep(p, (char*)lds_raw);
        if (1 < p.ph_hi) grid.sync();
        ph0 = 1;
    }
#pragma nounroll
    for (int ph = ph0; ph < p.ph_hi; ++ph) {
        const int ng = gemm_count(ph);
        if (ng > 0) {
#pragma nounroll
            for (int gi = 0; gi < ng; ++gi) { const GemmDesc d = make_desc(p, ph, gi); gemm_phase((LAS unsigned char*)lds_raw, d); }
        } else if (ph == PH_QKCONV) {
            phase_qk(p);
            phase_conv(p, (char*)lds_raw);
        } else if (ph == PH_ATTN) {
            phase_attn(p, (char*)lds_raw);
        } else if (ph == PH_LN1) {
            ln_rows((const float*)(ws + OFF_A), (float*)(ws + OFF_A), (bf16_t*)(ws + OFF_B), (const float*)(ws + OFF_SMALL) + SM_LN1G, (const float*)(ws + OFF_SMALL) + SM_LN1B);
        } else if (ph == PH_SOFTMAX) {
            phase_softmax(p);
        } else if (ph == PH_LN2) {
            ln_rows((const float*)(ws + OFF_A), (float*)(ws + OFF_A), (bf16_t*)(ws + OFF_B), (const float*)(ws + OFF_SMALL) + SM_LN2G, (const float*)(ws + OFF_SMALL) + SM_LN2B);
        } else if (ph == PH_LN3) {
            ln_rows((const float*)(ws + OFF_A), p.out, nullptr, (const float*)(ws + OFF_SMALL) + SM_LN3G, (const float*)(ws + OFF_SMALL) + SM_LN3B);
        }
        if (ph + 1 < p.ph_hi) grid.sync();
    }
}

extern "C" void kernel_launch(void* const* d_in, const int* in_sizes, int n_in, void* d_out, int out_size, void* d_ws, size_t ws_size, hipStream_t stream) {
    static int grid = 0;
    if (grid == 0) {
        if (n_in != 27 || ws_size < WS_END) { fprintf(stderr, "kernel_launch: unexpected n_in %d / ws_size %zu (need %zu)\n", n_in, ws_size, (size_t)WS_END); grid = -1; return; }
        int dev = 0, cus = 0, per_cu = 0;
        hipGetDevice(&dev);
        hipDeviceGetAttribute(&cus, hipDeviceAttributeMultiprocessorCount, dev);
        if (hipFuncSetAttribute((const void*)mega, hipFuncAttributeMaxDynamicSharedMemorySize, LDS_BYTES) != hipSuccess) { fprintf(stderr, "kernel_launch: hipFuncSetAttribute failed\n"); grid = -1; return; }
        if (hipOccupancyMaxActiveBlocksPerMultiprocessor(&per_cu, (const void*)mega, NTHR, LDS_BYTES) != hipSuccess || per_cu < 1) { fprintf(stderr, "kernel_launch: occupancy query says %d\n", per_cu); per_cu = 1; }
        (void)hipGetLastError();
        grid = cus * per_cu;
        fprintf(stderr, "kernel_launch: grid %d (cus %d x %d)\n", grid, cus, per_cu);
    }
    if (grid < 0) return;
    Params p{};
    for (int i = 0; i < 27; ++i) p.in[i] = (const float*)d_in[i];
    p.out = (float*)d_out; p.ws = (unsigned char*)d_ws; p.ph_lo = 0; p.ph_hi = PH_COUNT;
    void* args[] = {&p};
    hipError_t e = hipLaunchCooperativeKernel((const void*)mega, dim3(grid), dim3(NTHR), args, LDS_BYTES, stream);
    if (e != hipSuccess) fprintf(stderr, "kernel_launch: cooperative launch failed: %s (grid %d)\n", hipGetErrorString(e), grid);
}
```

```cpp
#include <hip/hip_runtime.h>
#include <hip/hip_cooperative_groups.h>
#include <cstdio>
#include <cstdint>
namespace cg = cooperative_groups;

#define LAS __attribute__((address_space(3)))
typedef unsigned short bf16_t;
typedef short bf16x8 __attribute__((ext_vector_type(8)));
typedef short s16x4 __attribute__((ext_vector_type(4)));
typedef float f32x4 __attribute__((ext_vector_type(4)));
typedef float f32x16 __attribute__((ext_vector_type(16)));
typedef unsigned u32x4 __attribute__((ext_vector_type(4)));
typedef unsigned u32x2 __attribute__((ext_vector_type(2)));

constexpr int NTHR = 512;
constexpr int BATCH = 8, SEQ = 2048, DM = 1024, MTOK = BATCH * SEQ, NMEM = 256, MMEM = BATCH * NMEM, DFF = 4096, INC = 1792;
constexpr float LN_EPS = 1e-5f;
constexpr float ALPHA = 1.189207115002721f;
constexpr int LDS_MAIN = 131072;
constexpr int LDS_BYTES = LDS_MAIN + 16;

constexpr size_t MiB = 1024 * 1024;
constexpr size_t OFF_WIN = 0;
constexpr size_t OFF_WOUT = OFF_WIN + (size_t)INC * DM * 2;
constexpr size_t OFF_WMQ = OFF_WOUT + (size_t)DM * DM * 2;
constexpr size_t OFF_WMKV = OFF_WMQ + (size_t)DM * DM * 2;
constexpr size_t OFF_WMO = OFF_WMKV + (size_t)2 * DM * DM * 2;
constexpr size_t OFF_WFF1 = OFF_WMO + (size_t)DM * DM * 2;
constexpr size_t OFF_WFF2 = OFF_WFF1 + (size_t)DFF * DM * 2;
constexpr size_t OFF_A = OFF_WFF2 + (size_t)DFF * DM * 2;
constexpr size_t OFF_B = OFF_A + 64 * MiB;
constexpr size_t OFF_REST = OFF_B + 32 * MiB;
constexpr size_t OFF_MEMB = OFF_REST;
constexpr size_t OFF_MEMK = OFF_REST + 4 * MiB;
constexpr size_t OFF_MEMVT = OFF_REST + 8 * MiB;
constexpr size_t OFF_T = OFF_REST + 12 * MiB;
constexpr size_t OFF_Y = OFF_T + 64 * MiB;
constexpr size_t OFF_Q = OFF_Y + 32 * MiB;
constexpr size_t OFF_KR = OFF_Q + 16 * MiB;
constexpr size_t OFF_A1 = OFF_REST;
constexpr size_t OFF_SMALL = OFF_REST + 128 * MiB;
constexpr size_t OFF_BAR = OFF_SMALL + 128 * 1024;
constexpr size_t BAR_BYTES = 16384;
constexpr size_t WS_END = OFF_BAR + BAR_BYTES;
constexpr int SM_QG = 0, SM_KG = 64, SM_CONVW = 128, SM_CONVB = SM_CONVW + 31 * 512, SM_CLNG = SM_CONVB + 512, SM_CLNB = SM_CLNG + 512,
              SM_AOG = SM_CLNB + 512, SM_COG = SM_AOG + 512, SM_LN1G = SM_COG + 512, SM_LN1B = SM_LN1G + 1024, SM_LN2G = SM_LN1B + 1024,
              SM_LN2B = SM_LN2G + 1024, SM_BFF1 = SM_LN2B + 1024, SM_BFF2 = SM_BFF1 + 4096, SM_LN3G = SM_BFF2 + 1024, SM_LN3B = SM_LN3G + 1024,
              SM_END = SM_LN3B + 1024;
static_assert(SM_END * 4 <= 128 * 1024, "small block");

struct Params {
    const float* in[27];
    float* out;
    unsigned char* ws;
    int ph_lo, ph_hi;
};

__device__ __forceinline__ unsigned cvt_pk_bf16(float lo, float hi) { unsigned r; asm volatile("v_cvt_pk_bf16_f32 %0, %1, %2" : "=v"(r) : "v"(lo), "v"(hi)); return r; }
__device__ __forceinline__ float bf2f(unsigned short b) { return __uint_as_float(((unsigned)b) << 16); }
__device__ __forceinline__ float bflo(unsigned w) { return __uint_as_float(w << 16); }
__device__ __forceinline__ float bfhi(unsigned w) { return __uint_as_float(w & 0xffff0000u); }
__device__ __forceinline__ float wave_sum(float v) {
#pragma unroll
    for (int o = 32; o > 0; o >>= 1) v += __shfl_xor(v, o);
    return v;
}
__device__ __forceinline__ float wave_max(float v) {
#pragma unroll
    for (int o = 32; o > 0; o >>= 1) v = fmaxf(v, __shfl_xor(v, o));
    return v;
}
__device__ __forceinline__ int otid() { int t = threadIdx.x; asm volatile("" : "+v"(t)); return t; }
__device__ __forceinline__ int obid() { int t = blockIdx.x; asm volatile("" : "+s"(t)); return t; }
__device__ __forceinline__ int ogrid() { int t = gridDim.x; asm volatile("" : "+s"(t)); return t; }
__device__ __forceinline__ float sigmoidf_(float x) { return __builtin_amdgcn_rcpf(1.f + __expf(-x)); }


#define XB_TMO      128
#define XB_XCNT(j)  (256  + 64 * (j))
#define XB_XSUB(j)  (1280 + 64 * (j))
#define XB_XGEN(j)  (2304 + 64 * (j))
#define XB_TOP      3328
#define XB_TOPGEN   3392
#define XCD_BAR_WORDS 3456
#define XB_SPIN_CAP (1u << 22)
static_assert(XCD_BAR_WORDS * 4 <= BAR_BYTES, "barrier words");
__device__ __forceinline__ unsigned xb_ld(unsigned* p)              { return __hip_atomic_load(p, __ATOMIC_RELAXED, __HIP_MEMORY_SCOPE_AGENT); }
__device__ __forceinline__ unsigned xb_add(unsigned* p, unsigned v) { return __hip_atomic_fetch_add(p, v, __ATOMIC_RELAXED, __HIP_MEMORY_SCOPE_AGENT); }
__device__ __forceinline__ unsigned xb_xcc_id() { return (unsigned)__builtin_amdgcn_s_getreg((3 << 11) | 20) & 0xFu; }
#define XB_SPIN(cond, bar) do { unsigned _sp = 0; while (cond) { __builtin_amdgcn_s_sleep(1); \
    if ((++_sp & 255u) == 0u) { if (xb_ld(&(bar)[XB_TMO])) break; if (_sp > XB_SPIN_CAP) { atomicAdd(&(bar)[XB_TMO], 1u); break; } } } } while (0)
struct XcdBarrier { unsigned* bar; unsigned x; volatile LAS unsigned* st; };
__device__ __forceinline__ XcdBarrier xcd_barrier_post(unsigned* bar, volatile LAS unsigned* st) {
    XcdBarrier b; b.bar = bar; b.x = xb_xcc_id(); b.st = st;
    if (threadIdx.x == 0) (void)xb_add(&bar[XB_XCNT(b.x)], 1u);
    return b;
}
__device__ __forceinline__ void xcd_barrier_complete(unsigned* bar, unsigned x, unsigned& nloc, unsigned& nx) {
    const unsigned G = gridDim.x * gridDim.y * gridDim.z;
    unsigned sum, cnt, mine, sp = 0u;
    for (;;) {
        sum = 0u; cnt = 0u; mine = 0u;
#pragma unroll
        for (unsigned j = 0; j < 16; ++j) { const unsigned c = xb_ld(&bar[XB_XCNT(j)]); sum += c; cnt += (c > 0u) ? 1u : 0u; mine = (j == x) ? c : mine; }
        if (sum == G) break;
        __builtin_amdgcn_s_sleep(1);
        if ((++sp & 255u) == 0u) { if (xb_ld(&bar[XB_TMO])) break; if (sp > XB_SPIN_CAP) { atomicAdd(&bar[XB_TMO], 1u); break; } }
    }
    nloc = mine > 0u ? mine : 1u; nx = cnt > 0u ? cnt : 1u;
}
__device__ __forceinline__ void xcd_barrier(const XcdBarrier& b) {
    asm volatile("s_waitcnt vmcnt(0)" ::: "memory");
    __syncthreads();
    if (threadIdx.x == 0) {
        unsigned* bar = b.bar;
        __builtin_amdgcn_s_waitcnt(0);
        unsigned nloc = b.st[0], nx = b.st[1];
        if (nloc == 0u) { xcd_barrier_complete(bar, b.x, nloc, nx); b.st[0] = nloc; b.st[1] = nx; }
        const unsigned old = xb_add(&bar[XB_XSUB(b.x)], 1u);
        const unsigned gen = old / nloc;
        if (old + 1u == (gen + 1u) * nloc) {
            __builtin_amdgcn_fence(__ATOMIC_RELEASE, "agent");
            asm volatile("s_waitcnt vmcnt(0)" ::: "memory");
            const unsigned og = xb_add(&bar[XB_TOP], 1u);
            const unsigned tg = og / nx;
            if (og + 1u == (tg + 1u) * nx) xb_add(&bar[XB_TOPGEN], 1u);
            else XB_SPIN(xb_ld(&bar[XB_TOPGEN]) == tg, bar);
            __builtin_amdgcn_fence(__ATOMIC_ACQUIRE, "agent");
            xb_add(&bar[XB_XGEN(b.x)], 1u);
            asm volatile("s_waitcnt vmcnt(0)" ::: "memory");
        } else {
            XB_SPIN(xb_ld(&bar[XB_XGEN(b.x)]) == gen, bar);
            __builtin_amdgcn_fence(__ATOMIC_ACQUIRE, "agent");
            asm volatile("s_waitcnt vmcnt(0)" ::: "memory");
        }
    }
    __syncthreads();
}

constexpr int BM = 256, BK = 64, HALF = 128, HTB = HALF * BK * 2, NXCD = 8, WGM = 8;

__device__ __forceinline__ int lds_byte(int r, int c) { const int st = (r >> 4) * 2 + (c >> 5), rr = r & 15, cc = c & 31, ob = rr * 64 + cc * 2; return st * 1024 + (ob ^ (((ob >> 9) & 1) << 5)); }
__device__ __forceinline__ void stage_rc(int b, int& R, int& C) { const int st = b / 1024, sb = b % 1024, swz = sb ^ (((sb >> 9) & 1) << 5); R = (st >> 1) * 16 + swz / 64; C = (st & 1) * 32 + (swz % 64) / 2; }
__device__ __forceinline__ int perm32(int rho) { const int n = rho >> 4, i = rho & 15; return 8 * (i >> 2) + 4 * n + (i & 3); }

struct GemmDesc {
    const bf16_t* A; const bf16_t* Bt; int lda, ldb, K;
    int nM, nN, nZ, zdiv;
    long sA0, sA1, sB0, sB1;
    int rz0, cz1;
    int shift;
    int kind;
    void* out; int ldc; const float* bias; float scale; int act; float alpha;
};
struct Unit { const char* a; const char* b; int row0, col0; };

__device__ __forceinline__ bool next_unit(const GemmDesc& d, int i, int G, int c, Unit& u) {
    const int per = d.nM * d.nN; const long L = (long)i * G + c;
    if (L >= (long)per * d.nZ) return false;
    const int z = (int)(L / per); int w = (int)(L % per); int pm, pn;
    if (d.nZ == 1) {
        const int nwg = per; const int q = nwg / NXCD, r = nwg % NXCD, xcd = w % NXCD, off = w / NXCD;
        w = (xcd < r ? xcd * (q + 1) : r * (q + 1) + (xcd - r) * q) + off;
        const int nig = WGM * d.nN, gid = w / nig, fm = gid * WGM, gsz = (d.nM - fm) < WGM ? (d.nM - fm) : WGM;
        pm = fm + ((w % nig) % gsz); pn = (w % nig) / gsz;
    } else { pm = w % d.nM; pn = w / d.nM; }
    const int z0 = z / d.zdiv, z1 = z % d.zdiv;
    u.a = (const char*)(d.A + (long)z0 * d.sA0 + (long)z1 * d.sA1 + (long)pm * BM * d.lda);
    u.b = (const char*)(d.Bt + (long)z0 * d.sB0 + (long)z1 * d.sB1 + (long)pn * BM * d.ldb);
    u.row0 = z0 * d.rz0 + pm * BM; u.col0 = z1 * d.cz1 + pn * BM;
    return true;
}

__device__ __forceinline__ void gemm_epilogue(const f32x4 (&acc)[2][2][4][2], const GemmDesc& d, const Unit& u, int wr, int wc, int fr, int fq) {
    const int row0 = u.row0 + wr * 64 + fr, col0 = u.col0 + wc * 32 + 8 * fq;
    f32x4 bv[2][2];
#pragma unroll
    for (int bj = 0; bj < 2; ++bj)
#pragma unroll
        for (int n = 0; n < 2; ++n) bv[bj][n] = d.bias ? *(const f32x4*)(d.bias + col0 + bj * HALF + 4 * n) : (f32x4){0.f, 0.f, 0.f, 0.f};
    const float sc = d.scale;
    if (d.kind == 0) {
        bf16_t* O = (bf16_t*)d.out;
#pragma unroll
        for (int ai = 0; ai < 2; ++ai)
#pragma unroll
            for (int m = 0; m < 4; ++m) {
                bf16_t* rowp = O + (size_t)(row0 + ai * HALF + m * 16) * d.ldc + col0;
#pragma unroll
                for (int bj = 0; bj < 2; ++bj) {
                    f32x4 v0 = acc[ai][bj][m][0] * sc + bv[bj][0], v1 = acc[ai][bj][m][1] * sc + bv[bj][1];
                    if (d.act == 1) {
#pragma unroll
                        for (int j = 0; j < 4; ++j) { float a = fmaxf(v0[j], 0.f), b = fmaxf(v1[j], 0.f); v0[j] = a * a; v1[j] = b * b; }
                    }
                    u32x4 w; w.x = cvt_pk_bf16(v0[0], v0[1]); w.y = cvt_pk_bf16(v0[2], v0[3]); w.z = cvt_pk_bf16(v1[0], v1[1]); w.w = cvt_pk_bf16(v1[2], v1[3]);
                    *(u32x4*)(rowp + bj * HALF) = w;
                }
            }
    } else {
        float* C = (float*)d.out; const float al = d.alpha;
#pragma unroll
        for (int ai = 0; ai < 2; ++ai)
#pragma unroll
            for (int m = 0; m < 4; ++m) {
                float* rowp = C + (size_t)(row0 + ai * HALF + m * 16) * d.ldc + col0;
#pragma unroll
                for (int bj = 0; bj < 2; ++bj) {
                    f32x4 v0 = acc[ai][bj][m][0] * sc + bv[bj][0], v1 = acc[ai][bj][m][1] * sc + bv[bj][1];
                    if (al != 0.f) { const f32x4 o0 = *(const f32x4*)(rowp + bj * HALF), o1 = *(const f32x4*)(rowp + bj * HALF + 4); v0 += o0 * al; v1 += o1 * al; }
                    *(f32x4*)(rowp + bj * HALF) = v0; *(f32x4*)(rowp + bj * HALF + 4) = v1;
                }
            }
    }
}

__device__ __forceinline__ void gemm_phase(LAS unsigned char* lds, const GemmDesc& d) {
    const int tid = otid(), wid = __builtin_amdgcn_readfirstlane(tid >> 6), lane = tid & 63, wr = wid >> 2, wc = wid & 3, fr = lane & 15, fq = lane >> 4;
    const int G = ogrid(); int cblk = obid() - d.shift; if (cblk < 0) cblk += G;
    const int K = d.K, nt = K / BK;
    unsigned voffA[2], voffB[2];
#pragma unroll
    for (int i = 0; i < 2; ++i) { int R, C; stage_rc(tid * 16 + i * 8192, R, C); const int Rb = (R & ~31) + perm32(R & 31);
        voffA[i] = (unsigned)(R * d.lda + C) * 2u; voffB[i] = (unsigned)(Rb * d.ldb + C) * 2u; }
    const size_t kstep = (size_t)(BK * 2);
    const size_t hstepA = (size_t)HALF * d.lda * 2, hstepB = (size_t)HALF * d.ldb * 2;
    const unsigned ldsw = (unsigned)wid * 1024u;
    const int aoff = lds_byte(wr * 64 + fr, fq * 8), boff = lds_byte(wc * 32 + fr, fq * 8);
#define PG8_SA(b, h) (((b) * 2 + (h)) * HTB)
#define PG8_SB(b, h) ((4 + (b) * 2 + (h)) * HTB)
#define PG8_STAGE(bufoff, gbase, voff) do { _Pragma("unroll") for (int _i = 0; _i < 2; ++_i) \
        __builtin_amdgcn_global_load_lds((const unsigned*)((const char*)(gbase) + (voff)[_i]), (LAS unsigned*)(lds + (bufoff) + ldsw + _i * 8192), 16, 0, 0); } while (0)
#define PG8_LDA(dst, b, h) do { _Pragma("unroll") for (int m = 0; m < 4; ++m) _Pragma("unroll") for (int k = 0; k < 2; ++k) dst[m][k] = *(const LAS bf16x8*)(lds + PG8_SA(b, h) + aoff + m * 2048 + k * 1024); } while (0)
#define PG8_LDB(dst, b, h) do { _Pragma("unroll") for (int n = 0; n < 2; ++n) _Pragma("unroll") for (int k = 0; k < 2; ++k) dst[n][k] = *(const LAS bf16x8*)(lds + PG8_SB(b, h) + boff + n * 2048 + k * 1024); } while (0)
#define PG8_MMA(ai, bj, At, Bt) do { __builtin_amdgcn_s_setprio(1); _Pragma("unroll") for (int m = 0; m < 4; ++m) _Pragma("unroll") for (int n = 0; n < 2; ++n) _Pragma("unroll") for (int k = 0; k < 2; ++k) \
        acc[ai][bj][m][n] = __builtin_amdgcn_mfma_f32_16x16x32_bf16(Bt[n][k], At[m][k], acc[ai][bj][m][n], 0, 0, 0); __builtin_amdgcn_s_setprio(0); } while (0)
#define PG8_WAIT_V(n) asm volatile("s_waitcnt vmcnt(" #n ")" ::: "memory")
#define PG8_WAIT_L(n) asm volatile("s_waitcnt lgkmcnt(" #n ")" ::: "memory")
#define PG8_BAR __builtin_amdgcn_s_barrier()
#define PG8_SCHED __builtin_amdgcn_sched_barrier(0)
    Unit cur, nxt; int ui = 0;
    if (!next_unit(d, 0, G, cblk, cur)) return;
    f32x4 acc[2][2][4][2];
#pragma unroll
    for (int a = 0; a < 2; ++a)
#pragma unroll
        for (int b = 0; b < 2; ++b)
#pragma unroll
            for (int m = 0; m < 4; ++m)
#pragma unroll
                for (int n = 0; n < 2; ++n) acc[a][b][m][n] = (f32x4){0.f, 0.f, 0.f, 0.f};
    bf16x8 At[4][2], B0[2][2], B1[2][2];
    const char* cA = cur.a; const char* cB = cur.b;
    PG8_STAGE(PG8_SB(0, 0), cB, voffB); PG8_STAGE(PG8_SA(0, 0), cA, voffA); PG8_STAGE(PG8_SB(0, 1), cB + hstepB, voffB); PG8_STAGE(PG8_SA(0, 1), cA + hstepA, voffA);
    if (wr == 1) PG8_BAR;
    PG8_WAIT_V(4); PG8_BAR;
    PG8_STAGE(PG8_SB(1, 0), cB + kstep, voffB); PG8_STAGE(PG8_SA(1, 0), cA + kstep, voffA); PG8_STAGE(PG8_SB(1, 1), cB + hstepB + kstep, voffB);
    PG8_WAIT_V(6); PG8_BAR;
    for (;;) {
        const bool has_next = next_unit(d, ui + 1, G, cblk, nxt);
        const char* nA = has_next ? nxt.a : cA; const char* nB = has_next ? nxt.b : cB;
        for (int t = 0; t < nt; t += 2) {
            const bool last = (t == nt - 2);
            const char* a1 = cA + (size_t)(t + 1) * kstep;
            const char* a2 = last ? nA : cA + (size_t)(t + 2) * kstep; const char* b2 = last ? nB : cB + (size_t)(t + 2) * kstep;
            const char* a3 = a2 + kstep; const char* b3 = b2 + kstep;
            PG8_LDB(B0, 0, 0); PG8_SCHED; PG8_LDA(At, 0, 0); PG8_STAGE(PG8_SA(1, 1), a1 + hstepA, voffA);
            PG8_WAIT_L(8); PG8_BAR; PG8_WAIT_L(0); PG8_MMA(0, 0, At, B0); PG8_BAR; PG8_SCHED;
            PG8_LDB(B1, 0, 1); PG8_STAGE(PG8_SB(0, 0), b2, voffB);
            PG8_BAR; PG8_WAIT_L(0); PG8_MMA(0, 1, At, B1); PG8_BAR;
            PG8_LDA(At, 0, 1); PG8_STAGE(PG8_SA(0, 0), a2, voffA);
            PG8_BAR; PG8_WAIT_L(0); PG8_MMA(1, 0, At, B0); PG8_BAR; PG8_SCHED;
            PG8_STAGE(PG8_SB(0, 1), b2 + hstepB, voffB);
            PG8_WAIT_V(6); PG8_BAR; PG8_MMA(1, 1, At, B1); PG8_BAR;
            PG8_LDB(B0, 1, 0); PG8_SCHED; PG8_LDA(At, 1, 0); PG8_STAGE(PG8_SA(0, 1), a2 + hstepA, voffA);
            PG8_WAIT_L(8); PG8_BAR; PG8_WAIT_L(0); PG8_MMA(0, 0, At, B0); PG8_BAR; PG8_SCHED;
            PG8_LDB(B1, 1, 1); PG8_STAGE(PG8_SB(1, 0), b3, voffB);
            PG8_BAR; PG8_WAIT_L(0); PG8_MMA(0, 1, At, B1); PG8_BAR;
            PG8_LDA(At, 1, 1); PG8_STAGE(PG8_SA(1, 0), a3, voffA);
            PG8_BAR; PG8_WAIT_L(0); PG8_MMA(1, 0, At, B0); PG8_BAR; PG8_SCHED;
            PG8_STAGE(PG8_SB(1, 1), b3 + hstepB, voffB);
            PG8_WAIT_V(6); PG8_BAR; PG8_MMA(1, 1, At, B1); PG8_BAR;
        }
        gemm_epilogue(acc, d, cur, wr, wc, fr, fq);
        if (!has_next) break;
#pragma unroll
        for (int a = 0; a < 2; ++a)
#pragma unroll
            for (int b = 0; b < 2; ++b)
#pragma unroll
                for (int m = 0; m < 4; ++m)
#pragma unroll
                    for (int n = 0; n < 2; ++n) acc[a][b][m][n] = (f32x4){0.f, 0.f, 0.f, 0.f};
        cur = nxt; cA = nA; cB = nB; ++ui;
    }
    PG8_WAIT_V(0);
    if (wr == 0) PG8_BAR;
    PG8_BAR;
#undef PG8_SA
#undef PG8_SB
#undef PG8_STAGE
#undef PG8_LDA
#undef PG8_LDB
#undef PG8_MMA
#undef PG8_WAIT_V
#undef PG8_WAIT_L
#undef PG8_BAR
#undef PG8_SCHED
}

namespace att {
constexpr int D = 64, NW = 8, QBLK = 32, KVBLK = 64;
constexpr float SCALE = 0.125f, THR = 8.f;
constexpr int SHM_V = KVBLK * D * 2, SHM_K = KVBLK * D * 2;
constexpr int LDQ = 512, LDK = 128, LDV = INC, LDY = DM;
#define KSWZ(row, colB) ((row) * 128 + ((colB) ^ ((((row) >> 1) & 7) << 4)))
#define SBAR() __builtin_amdgcn_sched_barrier(0)
__device__ __forceinline__ int crow(int r, int hi) { return (r & 3) + 8 * (r >> 2) + 4 * hi; }

__device__ __forceinline__ void partialSM(f32x16& p0, f32x16& p1, float& m_reg, float& mn, float& alpha) {
    constexpr float C = SCALE * 1.4426950408889634f;
    float pmax = p0[0];
#pragma unroll
    for (int r = 1; r < 16; ++r) pmax = fmaxf(pmax, p0[r]);
#pragma unroll
    for (int r = 0; r < 16; ++r) pmax = fmaxf(pmax, p1[r]);
    { auto rr = __builtin_amdgcn_permlane32_swap(__float_as_uint(pmax), __float_as_uint(pmax), false, false);
      pmax = fmaxf(__uint_as_float(rr[0]), __uint_as_float(rr[1])); }
    if (__builtin_expect(__all(pmax - m_reg <= THR / SCALE), 1)) { mn = m_reg; alpha = 1.f; }
    else { mn = fmaxf(m_reg, pmax); alpha = __builtin_amdgcn_exp2f((m_reg - mn) * C); m_reg = mn; }
    const float mnC = -mn * C;
#pragma unroll
    for (int r = 0; r < 16; ++r) p0[r] = fmaf(p0[r], C, mnC);
#pragma unroll
    for (int r = 0; r < 16; ++r) p1[r] = fmaf(p1[r], C, mnC);
#pragma unroll
    for (int r = 0; r < 16; ++r) p0[r] = __builtin_amdgcn_exp2f(p0[r]);
}
__device__ __forceinline__ void finishSM(f32x16& p0, f32x16& p1, float alpha, float& l_reg, bf16x8& pa0, bf16x8& pa1, bf16x8& pa2, bf16x8& pa3) {
#pragma unroll
    for (int r = 0; r < 16; ++r) p1[r] = __builtin_amdgcn_exp2f(p1[r]);
    float ps = 0;
#pragma unroll
    for (int r = 0; r < 16; ++r) ps += p0[r];
#pragma unroll
    for (int r = 0; r < 16; ++r) ps += p1[r];
    { auto rr = __builtin_amdgcn_permlane32_swap(__float_as_uint(ps), __float_as_uint(ps), false, false);
      ps = __uint_as_float(rr[0]) + __uint_as_float(rr[1]); }
    l_reg = l_reg * alpha + ps;
#define PK4(P, BASE, OUT) do { unsigned a0 = cvt_pk_bf16(P[BASE + 0], P[BASE + 1]), a1 = cvt_pk_bf16(P[BASE + 2], P[BASE + 3]);   \
    unsigned b0 = cvt_pk_bf16(P[BASE + 4], P[BASE + 5]), b1 = cvt_pk_bf16(P[BASE + 6], P[BASE + 7]);                              \
    auto r0 = __builtin_amdgcn_permlane32_swap(a0, b0, false, false); auto r1 = __builtin_amdgcn_permlane32_swap(a1, b1, false, false); \
    u32x4 w = {r0[0], r1[0], r0[1], r1[1]}; OUT = *reinterpret_cast<bf16x8*>(&w); } while (0)
    PK4(p0, 0, pa0); PK4(p0, 8, pa1); PK4(p1, 0, pa2); PK4(p1, 8, pa3);
#undef PK4
}
__device__ __forceinline__ void qkt(f32x16& p0, f32x16& p1, const char* Ks, const bf16x8* qr, int r32, int hi) {
    p0 = f32x16{}; p1 = f32x16{};
#pragma unroll
    for (int d0 = 0; d0 < 4; ++d0) { const int cb = (d0 * 16 + hi * 8) * 2;
        bf16x8 b0 = *reinterpret_cast<const bf16x8*>(Ks + KSWZ(r32, cb));
        bf16x8 b1 = *reinterpret_cast<const bf16x8*>(Ks + KSWZ(32 + r32, cb));
        p0 = __builtin_amdgcn_mfma_f32_32x32x16_bf16(b0, qr[d0], p0, 0, 0, 0);
        p1 = __builtin_amdgcn_mfma_f32_32x32x16_bf16(b1, qr[d0], p1, 0, 0, 0); }
}
__device__ __forceinline__ int v_st(int k, int c) { const int kk = (k & ~0xC) | ((k & 4) << 1) | ((k & 8) >> 1); return ((kk >> 3) * 2 + (c >> 5)) * 512 + ((kk & 7) * 32 + (c & 31)) * 2; }
__device__ __forceinline__ int v_rd_base(int lane) { return ((lane & 3) << 3) | (((lane >> 2) & 3) << 6) | (((lane >> 4) & 1) << 5) | (((lane >> 5) & 1) << 8); }
constexpr int v_rd_off(int d0, int ks, int half) { return d0 * 512 + ks * 2048 + half * 1024; }
template <int OFF> __device__ __forceinline__ s16x4 tr_read(int vb) {
    s16x4 r; asm volatile("ds_read_b64_tr_b16 %0, %1 offset:%2" : "=&v"(r) : "v"(vb), "i"(OFF) : "memory"); return r;
}
template <int D0> __device__ __forceinline__ void pv_one(f32x16& od, int vb, bf16x8 pa0, bf16x8 pa1, bf16x8 pa2, bf16x8 pa3) {
    const s16x4 l0 = tr_read<v_rd_off(D0, 0, 0)>(vb), h0 = tr_read<v_rd_off(D0, 0, 1)>(vb), l1 = tr_read<v_rd_off(D0, 1, 0)>(vb), h1 = tr_read<v_rd_off(D0, 1, 1)>(vb);
    const s16x4 l2 = tr_read<v_rd_off(D0, 2, 0)>(vb), h2 = tr_read<v_rd_off(D0, 2, 1)>(vb), l3 = tr_read<v_rd_off(D0, 3, 0)>(vb), h3 = tr_read<v_rd_off(D0, 3, 1)>(vb);
    asm volatile("s_waitcnt lgkmcnt(0)" ::: "memory"); SBAR();
#define PK(L, H) (bf16x8){L[0], L[1], L[2], L[3], H[0], H[1], H[2], H[3]}
    od = __builtin_amdgcn_mfma_f32_32x32x16_bf16(pa0, PK(l0, h0), od, 0, 0, 0);
    od = __builtin_amdgcn_mfma_f32_32x32x16_bf16(pa1, PK(l1, h1), od, 0, 0, 0);
    od = __builtin_amdgcn_mfma_f32_32x32x16_bf16(pa2, PK(l2, h2), od, 0, 0, 0);
    od = __builtin_amdgcn_mfma_f32_32x32x16_bf16(pa3, PK(l3, h3), od, 0, 0, 0);
#undef PK
}
__device__ __forceinline__ void pv_d0(f32x16* o, int vb, bf16x8 pa0, bf16x8 pa1, bf16x8 pa2, bf16x8 pa3) {
    pv_one<0>(o[0], vb, pa0, pa1, pa2, pa3); pv_one<1>(o[1], vb, pa0, pa1, pa2, pa3);
}

__device__ __forceinline__ void attn_body(const bf16_t* __restrict__ Qb, const bf16_t* __restrict__ Kh, const bf16_t* __restrict__ Vh,
                                          bf16_t* __restrict__ Yb, const float* __restrict__ gain, int seq, char* lds) {
    const int tid = otid(), wid = tid >> 6, lane = tid & 63, r32 = lane & 31, hi = lane >> 5;
    char* V_lds = lds; char* K_lds = lds + 2 * SHM_V;
    float* ws = (float*)(lds + 2 * SHM_V + 2 * SHM_K) + wid * 64; float* li_l = ws; float* al_l = ws + 32;
    float m_reg = -1e30f, l_reg = 0; f32x16 o[2] = {}; bf16x8 qr[4];
    const bf16_t* Qw = Qb + (long)(wid * QBLK + r32) * LDQ + hi * 8;
#pragma unroll
    for (int d0 = 0; d0 < 4; ++d0) qr[d0] = *reinterpret_cast<const bf16x8*>(Qw + d0 * 16);
    const int sr = tid >> 3, sc = (tid & 7) * 8, vst0 = v_st(sr, sc), kst0 = KSWZ(sr, sc * 2);
    const int vb0 = (int)(uintptr_t)V_lds + v_rd_base(lane);
    bf16x8 vsE, ksE, vsO, ksO;
#define SLOADE(k0) do { vsE = *reinterpret_cast<const bf16x8*>(&Vh[(long)((k0) + sr) * LDV + sc]); ksE = *reinterpret_cast<const bf16x8*>(&Kh[(long)((k0) + sr) * LDK + sc]); } while (0)
#define SLOADO(k0) do { vsO = *reinterpret_cast<const bf16x8*>(&Vh[(long)((k0) + sr) * LDV + sc]); ksO = *reinterpret_cast<const bf16x8*>(&Kh[(long)((k0) + sr) * LDK + sc]); } while (0)
#define SWRITEE(b) do { *(bf16x8*)(V_lds + (b) * SHM_V + vst0) = vsE; *(bf16x8*)(K_lds + (b) * SHM_K + kst0) = ksE; } while (0)
#define SWRITEO(b) do { *(bf16x8*)(V_lds + (b) * SHM_V + vst0) = vsO; *(bf16x8*)(K_lds + (b) * SHM_K + kst0) = ksO; } while (0)
#define SWAIT() asm volatile("s_waitcnt vmcnt(2)" ::: "memory")
#define RESC(a) do { if (__any((a) < 1.f)) { if (hi == 0) al_l[r32] = (a); asm volatile("s_waitcnt lgkmcnt(0)" ::: "memory"); \
    _Pragma("unroll") for (int dd = 0; dd < 2; ++dd) _Pragma("unroll") for (int r = 0; r < 16; ++r) o[dd][r] *= al_l[crow(r, hi)]; } } while (0)
    f32x16 pA0, pA1, pB0, pB1; float mnA, mnB, alA, alB; bf16x8 pa0, pa1, pa2, pa3; const int NTL = seq / KVBLK;
    SLOADE(0); asm volatile("s_waitcnt vmcnt(0)" ::: "memory"); SWRITEE(0); __syncthreads();
    qkt(pA0, pA1, K_lds, qr, r32, hi); partialSM(pA0, pA1, m_reg, mnA, alA);
    SLOADO(KVBLK); if (2 < NTL) SLOADE(2 * KVBLK);
    SWAIT(); SWRITEO(1); __syncthreads();
    for (int j = 1; j + 1 < NTL; j += 2) {
        SBAR(); qkt(pB0, pB1, K_lds + SHM_K, qr, r32, hi);
        finishSM(pA0, pA1, alA, l_reg, pa0, pa1, pa2, pa3); SBAR();
        SLOADO((j + 2) * KVBLK); SBAR();
        pv_d0(o, vb0, pa0, pa1, pa2, pa3); partialSM(pB0, pB1, m_reg, mnB, alB);
        __syncthreads(); SWAIT(); SWRITEE(0);
        RESC(alB); __syncthreads();
        SBAR(); qkt(pA0, pA1, K_lds, qr, r32, hi);
        finishSM(pB0, pB1, alB, l_reg, pa0, pa1, pa2, pa3); SBAR();
        if (j + 3 < NTL) SLOADE((j + 3) * KVBLK); SBAR();
        pv_d0(o, vb0 + SHM_V, pa0, pa1, pa2, pa3); partialSM(pA0, pA1, m_reg, mnA, alA);
        __syncthreads(); SWAIT(); SWRITEO(1);
        RESC(alA); __syncthreads();
    }
    SBAR(); qkt(pB0, pB1, K_lds + SHM_K, qr, r32, hi);
    finishSM(pA0, pA1, alA, l_reg, pa0, pa1, pa2, pa3); SBAR();
    pv_d0(o, vb0, pa0, pa1, pa2, pa3); partialSM(pB0, pB1, m_reg, mnB, alB);
    __syncthreads(); RESC(alB);
    finishSM(pB0, pB1, alB, l_reg, pa0, pa1, pa2, pa3); SBAR();
    pv_d0(o, vb0 + SHM_V, pa0, pa1, pa2, pa3);
    if (hi == 0) li_l[r32] = l_reg; asm volatile("s_waitcnt lgkmcnt(0)" ::: "memory");
    const float g0 = gain[r32], g1 = gain[32 + r32];
    bf16_t* Yw = Yb + (long)(wid * QBLK) * LDY;
#pragma unroll
    for (int r = 0; r < 16; ++r) {
        const int orow = crow(r, hi);
        const float rl = __builtin_amdgcn_rcpf(li_l[orow]);
        const float a = o[0][r] * rl, b = o[1][r] * rl;
        float ss = a * a + b * b;
        ss += __shfl_xor(ss, 1); ss += __shfl_xor(ss, 2); ss += __shfl_xor(ss, 4); ss += __shfl_xor(ss, 8); ss += __shfl_xor(ss, 16);
        const float rs = rsqrtf(ss * (1.f / 64.f) + LN_EPS);
        const unsigned wa = cvt_pk_bf16(a * rs * g0, b * rs * g1);
        Yw[(long)orow * LDY + r32] = (bf16_t)(wa & 0xffffu);
        Yw[(long)orow * LDY + 32 + r32] = (bf16_t)(wa >> 16);
    }
    __syncthreads();
#undef SLOADE
#undef SLOADO
#undef SWRITEE
#undef SWRITEO
#undef SWAIT
#undef RESC
}
}

__device__ __forceinline__ void ln_rows(const float* src, float* dstf, bf16_t* dstb, const float* __restrict__ g, const float* __restrict__ b) {
    const int tid = otid(), lane = tid & 63, wid = tid >> 6;
    const int nw = ogrid() * 8;
    f32x4 gv[4], bv[4];
#pragma unroll
    for (int j = 0; j < 4; ++j) { gv[j] = *(const f32x4*)(g + j * 256 + lane * 4); bv[j] = *(const f32x4*)(b + j * 256 + lane * 4); }
    for (int row = obid() * 8 + wid; row < MTOK; row += nw) {
        const float* sp = src + (size_t)row * DM;
        f32x4 v[4];
#pragma unroll
        for (int j = 0; j < 4; ++j) v[j] = *(const f32x4*)(sp + j * 256 + lane * 4);
        float s = 0.f;
#pragma unroll
        for (int j = 0; j < 4; ++j) s += v[j][0] + v[j][1] + v[j][2] + v[j][3];
        const float mean = wave_sum(s) * (1.f / DM);
        float q = 0.f;
#pragma unroll
        for (int j = 0; j < 4; ++j) { v[j] -= mean; q += v[j][0] * v[j][0] + v[j][1] * v[j][1] + v[j][2] * v[j][2] + v[j][3] * v[j][3]; }
        const float rstd = rsqrtf(wave_sum(q) * (1.f / DM) + LN_EPS);
#pragma unroll
        for (int j = 0; j < 4; ++j) {
            const f32x4 y = v[j] * rstd * gv[j] + bv[j];
            if (dstf) *(f32x4*)(dstf + (size_t)row * DM + j * 256 + lane * 4) = y;
            if (dstb) { u32x2 w; w.x = cvt_pk_bf16(y[0], y[1]); w.y = cvt_pk_bf16(y[2], y[3]); *(u32x2*)(dstb + (size_t)row * DM + j * 256 + lane * 4) = w; }
        }
    }
}

__device__ __forceinline__ void transpose_tile(const float* __restrict__ W, bf16_t* __restrict__ Wt, int K, int N, int tile, float* tl) {
    const int tn = N >> 6; const int k0 = (tile / tn) * 64, n0 = (tile % tn) * 64; const int tid = otid();
#pragma unroll
    for (int i = 0; i < 8; ++i) { const int idx = tid + i * NTHR, kk = idx >> 6, nn = idx & 63; tl[kk * 65 + nn] = W[(size_t)(k0 + kk) * N + n0 + nn]; }
    __syncthreads();
    { const int nn = tid >> 3, kc = (tid & 7) * 8; float v[8];
#pragma unroll
      for (int j = 0; j < 8; ++j) v[j] = tl[(kc + j) * 65 + nn];
      u32x4 w; w.x = cvt_pk_bf16(v[0], v[1]); w.y = cvt_pk_bf16(v[2], v[3]); w.z = cvt_pk_bf16(v[4], v[5]); w.w = cvt_pk_bf16(v[6], v[7]);
      *(u32x4*)(Wt + (size_t)(n0 + nn) * K + k0 + kc) = w; }
    __syncthreads();
}

__device__ __forceinline__ void phase_prep(const Params& p, char* lds) {
    unsigned char* ws = p.ws; float* tl = (float*)lds;
    constexpr int T0 = 448, T1 = T0 + 256, T2 = T1 + 256, T3 = T2 + 512, T4 = T3 + 256, T5 = T4 + 1024, T6 = T5 + 1024;
    for (int t = blockIdx.x; t < T6; t += gridDim.x) {
        if (t < T0) transpose_tile(p.in[4], (bf16_t*)(ws + OFF_WIN), DM, INC, t, tl);
        else if (t < T1) transpose_tile(p.in[13], (bf16_t*)(ws + OFF_WOUT), DM, DM, t - T0, tl);
        else if (t < T2) transpose_tile(p.in[16], (bf16_t*)(ws + OFF_WMQ), DM, DM, t - T1, tl);
        else if (t < T3) transpose_tile(p.in[17], (bf16_t*)(ws + OFF_WMKV), DM, 2 * DM, t - T2, tl);
        else if (t < T4) transpose_tile(p.in[18], (bf16_t*)(ws + OFF_WMO), DM, DM, t - T3, tl);
        else if (t < T5) transpose_tile(p.in[21], (bf16_t*)(ws + OFF_WFF1), DM, DFF, t - T4, tl);
        else transpose_tile(p.in[23], (bf16_t*)(ws + OFF_WFF2), DFF, DM, t - T5, tl);
    }
    { float* sm = (float*)(ws + OFF_SMALL); const int gt = blockIdx.x * NTHR + threadIdx.x, gs = gridDim.x * NTHR;
#define CPY(idx, off, n) for (int i = gt; i < (n); i += gs) sm[(off) + i] = p.in[idx][i];
      CPY(5, SM_QG, 64) CPY(6, SM_KG, 64) CPY(7, SM_CONVW, 31 * 512) CPY(8, SM_CONVB, 512) CPY(9, SM_CLNG, 512) CPY(10, SM_CLNB, 512)
      CPY(11, SM_AOG, 512) CPY(12, SM_COG, 512) CPY(14, SM_LN1G, 1024) CPY(15, SM_LN1B, 1024) CPY(19, SM_LN2G, 1024) CPY(20, SM_LN2B, 1024)
      CPY(22, SM_BFF1, 4096) CPY(24, SM_BFF2, 1024) CPY(25, SM_LN3G, 1024) CPY(26, SM_LN3B, 1024)
#undef CPY
    }
    ln_rows(p.in[0], (float*)(ws + OFF_A), (bf16_t*)(ws + OFF_B), p.in[2], p.in[3]);
    { const float* mem = p.in[1]; bf16_t* mb = (bf16_t*)(ws + OFF_MEMB);
      for (size_t i = ((size_t)blockIdx.x * NTHR + threadIdx.x) * 8; i < (size_t)MMEM * DM; i += (size_t)gridDim.x * NTHR * 8) {
          const f32x4 a = *(const f32x4*)(mem + i), b = *(const f32x4*)(mem + i + 4);
          u32x4 w; w.x = cvt_pk_bf16(a[0], a[1]); w.y = cvt_pk_bf16(a[2], a[3]); w.z = cvt_pk_bf16(b[0], b[1]); w.w = cvt_pk_bf16(b[2], b[3]);
          *(u32x4*)(mb + i) = w; } }
}

__device__ __forceinline__ void phase_qk(const Params& p) {
    const bf16_t* proj = (const bf16_t*)(p.ws + OFF_T);
    bf16_t* qR = (bf16_t*)(p.ws + OFF_Q); bf16_t* kR = (bf16_t*)(p.ws + OFF_KR);
    const float* sm = (const float*)(p.ws + OFF_SMALL); const float* qg = sm + SM_QG; const float* kg = sm + SM_KG;
    const long total = (long)MTOK * 80;
    for (long g = (long)obid() * NTHR + otid(); g < total; g += (long)ogrid() * NTHR) {
        const int tok = (int)(g / 80), ch = (int)(g % 80), head = ch >> 3, part = ch & 7;
        const int col = (head < 8) ? head * 64 : 512 + (head - 8) * 64;
        const u32x4 raw = *(const u32x4*)(proj + (size_t)tok * INC + col + part * 8);
        float x[8]; x[0] = bflo(raw.x); x[1] = bfhi(raw.x); x[2] = bflo(raw.y); x[3] = bfhi(raw.y); x[4] = bflo(raw.z); x[5] = bfhi(raw.z); x[6] = bflo(raw.w); x[7] = bfhi(raw.w);
        float ss = 0.f;
#pragma unroll
        for (int j = 0; j < 8; ++j) ss += x[j] * x[j];
        ss += __shfl_xor(ss, 1); ss += __shfl_xor(ss, 2); ss += __shfl_xor(ss, 4);
        const float rs = rsqrtf(ss * (1.f / 64.f) + LN_EPS);
        const float* gp = (head < 8 ? qg : kg) + part * 8;
        const f32x4 ga = *(const f32x4*)gp, gb = *(const f32x4*)(gp + 4);
        x[0] *= rs * ga[0]; x[1] *= rs * ga[1]; x[2] *= rs * ga[2]; x[3] *= rs * ga[3];
        x[4] *= rs * gb[0]; x[5] *= rs * gb[1]; x[6] *= rs * gb[2]; x[7] *= rs * gb[3];
        const int s = tok & (SEQ - 1);
        const float pos = (float)((part < 4) ? (s >> 6) : (s & 63));
        float y[8];
#pragma unroll
        for (int jj = 0; jj < 4; ++jj) {
            const int fi = (part & 3) * 4 + jj;
            const float inv = exp2f(-(float)fi * (13.287712379549449f / 16.f));
            const float ang = pos * inv;
            float sn, cs; __sincosf(ang, &sn, &cs);
            y[2 * jj] = x[2 * jj] * cs - x[2 * jj + 1] * sn;
            y[2 * jj + 1] = x[2 * jj] * sn + x[2 * jj + 1] * cs;
        }
        u32x4 w; w.x = cvt_pk_bf16(y[0], y[1]); w.y = cvt_pk_bf16(y[2], y[3]); w.z = cvt_pk_bf16(y[4], y[5]); w.w = cvt_pk_bf16(y[6], y[7]);
        if (head < 8) *(u32x4*)(qR + (size_t)tok * 512 + head * 64 + part * 8) = w;
        else *(u32x4*)(kR + (size_t)tok * 128 + (head - 8) * 64 + part * 8) = w;
    }
}

constexpr int CT = 16, CROWS = CT + 30;
__device__ __forceinline__ void phase_conv(const Params& p, char* lds) {
    const bf16_t* proj = (const bf16_t*)(p.ws + OFF_T);
    bf16_t* Y = (bf16_t*)(p.ws + OFF_Y);
    const float* sm = (const float*)(p.ws + OFF_SMALL);
    float* U = (float*)lds;
    float* red = (float*)(lds + CROWS * 512 * 4);
    const int tid = otid(), c = tid, lane = tid & 63, wid = tid >> 6;
    float w[31];
#pragma unroll
    for (int j = 0; j < 31; ++j) w[j] = sm[SM_CONVW + j * 512 + c];
    const float cb = sm[SM_CONVB + c], lg = sm[SM_CLNG + c], lb = sm[SM_CLNB + c], og = sm[SM_COG + c];
    for (int tile = obid(); tile < MTOK / CT; tile += ogrid()) {
        const int tok0 = tile * CT, bb = tok0 / SEQ, s0 = tok0 % SEQ;
        for (int q = tid; q < CROWS * 64; q += NTHR) {
            const int r = q >> 6, c8 = (q & 63) * 8; const int s = s0 - 15 + r;
            f32x4 u0 = {0.f, 0.f, 0.f, 0.f}, u1 = {0.f, 0.f, 0.f, 0.f};
            if (s >= 0 && s < SEQ) {
                const bf16_t* rp = proj + (size_t)(bb * SEQ + s) * INC;
                const u32x4 vv = *(const u32x4*)(rp + 768 + c8), gg = *(const u32x4*)(rp + 1280 + c8);
                u0[0] = bflo(vv.x) * sigmoidf_(bflo(gg.x)); u0[1] = bfhi(vv.x) * sigmoidf_(bfhi(gg.x));
                u0[2] = bflo(vv.y) * sigmoidf_(bflo(gg.y)); u0[3] = bfhi(vv.y) * sigmoidf_(bfhi(gg.y));
                u1[0] = bflo(vv.z) * sigmoidf_(bflo(gg.z)); u1[1] = bfhi(vv.z) * sigmoidf_(bfhi(gg.z));
                u1[2] = bflo(vv.w) * sigmoidf_(bflo(gg.w)); u1[3] = bfhi(vv.w) * sigmoidf_(bfhi(gg.w));
            }
            *(f32x4*)(U + r * 512 + c8) = u0; *(f32x4*)(U + r * 512 + c8 + 4) = u1;
        }
        __syncthreads();
        float acc[CT];
#pragma unroll
        for (int t = 0; t < CT; ++t) acc[t] = cb;
#pragma unroll
        for (int r = 0; r < CROWS; ++r) {
            const float uv = U[r * 512 + c];
#pragma unroll
            for (int t = 0; t < CT; ++t) { const int j = r - t; if (j >= 0 && j <= 30) acc[t] = fmaf(uv, w[j], acc[t]); }
        }
#pragma unroll
        for (int t = 0; t < CT; ++t) {
            const float s1 = wave_sum(acc[t]), s2 = wave_sum(acc[t] * acc[t]);
            if (lane == 0) { red[(wid * CT + t) * 2] = s1; red[(wid * CT + t) * 2 + 1] = s2; }
        }
        __syncthreads();
#pragma unroll
        for (int t = 0; t < CT; ++t) {
            float s1 = 0.f, s2 = 0.f;
#pragma unroll
            for (int ww = 0; ww < 8; ++ww) { s1 += red[(ww * CT + t) * 2]; s2 += red[(ww * CT + t) * 2 + 1]; }
            const float mean = s1 * (1.f / 512.f); const float var = fmaxf(s2 * (1.f / 512.f) - mean * mean, 0.f);
            const float yv = (acc[t] - mean) * rsqrtf(var + LN_EPS) * lg + lb;
            const float sv = yv * sigmoidf_(yv);
            const float gs = wave_sum(sv * sv);
            const float ov = sv * rsqrtf(gs * (1.f / 64.f) + LN_EPS) * og;
            const unsigned pk = cvt_pk_bf16(ov, 0.f);
            Y[(size_t)(tok0 + t) * DM + 512 + c] = (bf16_t)(pk & 0xffffu);
        }
        __syncthreads();
    }
}

__device__ __forceinline__ void phase_attn(const Params& p, char* lds) {
    const bf16_t* proj = (const bf16_t*)(p.ws + OFF_T);
    const bf16_t* qR = (const bf16_t*)(p.ws + OFF_Q); const bf16_t* kR = (const bf16_t*)(p.ws + OFF_KR);
    bf16_t* Y = (bf16_t*)(p.ws + OFF_Y);
    for (int item = obid(); item < BATCH * 8 * (SEQ / 256); item += ogrid()) {
        const int qb = item & 7, h = (item >> 3) & 7, b = item >> 6, kvh = h >> 2;
        const size_t tok0 = (size_t)b * SEQ;
        att::attn_body(qR + (tok0 + qb * 256) * 512 + h * 64, kR + tok0 * 128 + kvh * 64, proj + tok0 * INC + 640 + kvh * 64,
                       Y + (tok0 + qb * 256) * DM + h * 64, (const float*)(p.ws + OFF_SMALL) + SM_AOG + h * 64, SEQ, lds);
    }
}

__device__ __forceinline__ void phase_softmax(const Params& p) {
    const float* Sc = (const float*)(p.ws + OFF_T); bf16_t* P = (bf16_t*)(p.ws + OFF_Y);
    const int tid = otid(), lane = tid & 63, wid = tid >> 6; const int nw = ogrid() * 8;
    for (int row = obid() * 8 + wid; row < MTOK; row += nw) {
#pragma unroll
        for (int h = 0; h < 4; ++h) {
            const f32x4 v = *(const f32x4*)(Sc + (size_t)row * DM + h * 256 + lane * 4);
            const float mx = wave_max(fmaxf(fmaxf(v[0], v[1]), fmaxf(v[2], v[3])));
            const float e0 = __expf(v[0] - mx), e1 = __expf(v[1] - mx), e2 = __expf(v[2] - mx), e3 = __expf(v[3] - mx);
            const float inv = 1.f / wave_sum(e0 + e1 + e2 + e3);
            u32x2 w; w.x = cvt_pk_bf16(e0 * inv, e1 * inv); w.y = cvt_pk_bf16(e2 * inv, e3 * inv);
            *(u32x2*)(P + (size_t)row * DM + h * 256 + lane * 4) = w;
        }
    }
}

__device__ __forceinline__ GemmDesc plain_gemm(const bf16_t* A, int lda, const bf16_t* Bt, int ldb, int M, int N, int K, int shift,
                                               int kind, void* out, int ldc, const float* bias, float scale, int act, float alpha) {
    GemmDesc d; d.A = A; d.Bt = Bt; d.lda = lda; d.ldb = ldb; d.K = K; d.nM = M / BM; d.nN = N / BM; d.nZ = 1; d.zdiv = 1;
    d.sA0 = d.sA1 = d.sB0 = d.sB1 = 0; d.rz0 = 0; d.cz1 = 0; d.shift = shift; d.kind = kind; d.out = out; d.ldc = ldc; d.bias = bias; d.scale = scale; d.act = act; d.alpha = alpha;
    return d;
}

enum { PH_PREP = 0, PH_G1, PH_QKCONV, PH_ATTN, PH_G2, PH_LN1, PH_G3, PH_G4, PH_SOFTMAX, PH_G5, PH_G6, PH_LN2, PH_G7, PH_G8, PH_LN3, PH_COUNT };

__device__ __forceinline__ int gemm_count(int ph) {
    switch (ph) { case PH_G1: return 3; case PH_G2: case PH_G3: case PH_G4: case PH_G5: case PH_G6: case PH_G7: case PH_G8: return 1; default: return 0; }
}
__device__ __forceinline__ GemmDesc make_desc(const Params& p, int ph, int gi) {
    unsigned char* ws = p.ws;
    const bf16_t* Bh = (const bf16_t*)(ws + OFF_B);
    switch (ph) {
    case PH_G1:
        if (gi == 0) return plain_gemm(Bh, DM, (const bf16_t*)(ws + OFF_WIN), DM, MTOK, INC, DM, 0, 0, ws + OFF_T, INC, nullptr, 1.f, 0, 0.f);
        if (gi == 1) return plain_gemm((const bf16_t*)(ws + OFF_MEMB), DM, (const bf16_t*)(ws + OFF_WMKV), DM, MMEM, DM, DM, 192, 0, ws + OFF_MEMK, DM, nullptr, 1.f, 0, 0.f);
        return plain_gemm((const bf16_t*)(ws + OFF_WMKV) + (size_t)DM * DM, DM, (const bf16_t*)(ws + OFF_MEMB), DM, DM, MMEM, DM, 224, 0, ws + OFF_MEMVT, MMEM, nullptr, 1.f, 0, 0.f);
    case PH_G2:
        return plain_gemm((const bf16_t*)(ws + OFF_Y), DM, (const bf16_t*)(ws + OFF_WOUT), DM, MTOK, DM, DM, 0, 1, ws + OFF_A, DM, nullptr, 1.f, 0, ALPHA);
    case PH_G3:
        return plain_gemm(Bh, DM, (const bf16_t*)(ws + OFF_WMQ), DM, MTOK, DM, DM, 0, 0, ws + OFF_Y, DM, nullptr, 1.f, 0, 0.f);
    case PH_G4: {
        GemmDesc d = plain_gemm((const bf16_t*)(ws + OFF_Y), DM, (const bf16_t*)(ws + OFF_MEMK), DM, SEQ, NMEM, 256, 0, 1, ws + OFF_T, DM, nullptr, 0.0625f, 0, 0.f);
        d.nZ = BATCH * 4; d.zdiv = 4; d.sA0 = (long)SEQ * DM; d.sA1 = 256; d.sB0 = (long)NMEM * DM; d.sB1 = 256; d.rz0 = SEQ; d.cz1 = 256; return d; }
    case PH_G5: {
        GemmDesc d = plain_gemm((const bf16_t*)(ws + OFF_Y), DM, (const bf16_t*)(ws + OFF_MEMVT), MMEM, SEQ, 256, 256, 0, 0, ws + OFF_T, DM, nullptr, 1.f, 0, 0.f);
        d.nZ = BATCH * 4; d.zdiv = 4; d.sA0 = (long)SEQ * DM; d.sA1 = 256; d.sB0 = NMEM; d.sB1 = (long)256 * MMEM; d.rz0 = SEQ; d.cz1 = 256; return d; }
    case PH_G6:
        return plain_gemm((const bf16_t*)(ws + OFF_T), DM, (const bf16_t*)(ws + OFF_WMO), DM, MTOK, DM, DM, 0, 1, ws + OFF_A, DM, nullptr, 1.f, 0, ALPHA);
    case PH_G7:
        return plain_gemm(Bh, DM, (const bf16_t*)(ws + OFF_WFF1), DM, MTOK, DFF, DM, 0, 0, ws + OFF_A1, DFF, (const float*)(ws + OFF_SMALL) + SM_BFF1, 1.f, 1, 0.f);
    default:
        return plain_gemm((const bf16_t*)(ws + OFF_A1), DFF, (const bf16_t*)(ws + OFF_WFF2), DFF, MTOK, DM, DFF, 0, 1, ws + OFF_A, DM, (const float*)(ws + OFF_SMALL) + SM_BFF2, 1.f, 0, ALPHA);
    }
}

__global__ void __launch_bounds__(NTHR) mega(Params p) {
    extern __shared__ __attribute__((aligned(16))) unsigned char lds_raw[];
    cg::grid_group grid = cg::this_grid();
    unsigned char* ws = p.ws;
    volatile LAS unsigned* bst = (volatile LAS unsigned*)((LAS unsigned char*)lds_raw + LDS_MAIN);
    if (threadIdx.x < 4) bst[threadIdx.x] = 0u;
    __syncthreads();
    const XcdBarrier xb = xcd_barrier_post((unsigned*)(ws + OFF_BAR), bst);
    int ph0 = p.ph_lo;
    if (ph0 == PH_PREP) {
        phase_prep(p, (char*)lds_raw);
        if (1 < p.ph_hi) grid.sync();
        ph0 = 1;
    }
#pragma nounroll
    for (int ph = ph0; ph < p.ph_hi; ++ph) {
        const int ng = gemm_count(ph);
        if (ng > 0) {
#pragma nounroll
            for (int gi = 0; gi < ng; ++gi) { const GemmDesc d = make_desc(p, ph, gi); gemm_phase((LAS unsigned char*)lds_raw, d); }
        } else if (ph == PH_QKCONV) {
            phase_qk(p);
            phase_conv(p, (char*)lds_raw);
        } else if (ph == PH_ATTN) {
            phase_attn(p, (char*)lds_raw);
        } else if (ph == PH_LN1) {
            ln_rows((const float*)(ws + OFF_A), (float*)(ws + OFF_A), (bf16_t*)(ws + OFF_B), (const float*)(ws + OFF_SMALL) + SM_LN1G, (const float*)(ws + OFF_SMALL) + SM_LN1B);
        } else if (ph == PH_SOFTMAX) {
            phase_softmax(p);
        } else if (ph == PH_LN2) {
            ln_rows((const float*)(ws + OFF_A), (float*)(ws + OFF_A), (bf16_t*)(ws + OFF_B), (const float*)(ws + OFF_SMALL) + SM_LN2G, (const float*)(ws + OFF_SMALL) + SM_LN2B);
        } else if (ph == PH_LN3) {
            ln_rows((const float*)(ws + OFF_A), p.out, nullptr, (const float*)(ws + OFF_SMALL) + SM_LN3G, (const float*)(ws + OFF_SMALL) + SM_LN3B);
        }
        if (ph + 1 < p.ph_hi) xcd_barrier(xb);
    }
}

extern "C" void kernel_launch(void* const* d_in, const int* in_sizes, int n_in, void* d_out, int out_size, void* d_ws, size_t ws_size, hipStream_t stream) {
    static int grid = 0;
    if (grid == 0) {
        if (n_in != 27 || ws_size < WS_END) { fprintf(stderr, "kernel_launch: unexpected n_in %d / ws_size %zu (need %zu)\n", n_in, ws_size, (size_t)WS_END); grid = -1; return; }
        int dev = 0, cus = 0, per_cu = 0;
        (void)hipGetDevice(&dev);
        (void)hipDeviceGetAttribute(&cus, hipDeviceAttributeMultiprocessorCount, dev);
        if (hipFuncSetAttribute((const void*)mega, hipFuncAttributeMaxDynamicSharedMemorySize, LDS_BYTES) != hipSuccess) { fprintf(stderr, "kernel_launch: hipFuncSetAttribute failed\n"); grid = -1; return; }
        if (hipOccupancyMaxActiveBlocksPerMultiprocessor(&per_cu, (const void*)mega, NTHR, LDS_BYTES) != hipSuccess || per_cu < 1) { fprintf(stderr, "kernel_launch: occupancy query says %d\n", per_cu); per_cu = 1; }
        (void)hipGetLastError();
        grid = cus * per_cu;
        fprintf(stderr, "kernel_launch: grid %d (cus %d x %d)\n", grid, cus, per_cu);
    }
    if (grid < 0) return;
    Params p{};
    for (int i = 0; i < 27; ++i) p.in[i] = (const float*)d_in[i];
    p.out = (float*)d_out; p.ws = (unsigned char*)d_ws; p.ph_lo = 0; p.ph_hi = PH_COUNT;
    if (hipMemsetAsync((char*)d_ws + OFF_BAR, 0, BAR_BYTES, stream) != hipSuccess) { fprintf(stderr, "kernel_launch: memset failed\n"); return; }
    void* args[] = {&p};
    hipError_t e = hipLaunchCooperativeKernel((const void*)mega, dim3(grid), dim3(NTHR), args, LDS_BYTES, stream);
    if (e != hipSuccess) fprintf(stderr, "kernel_launch: cooperative launch failed: %s (grid %d)\n", hipGetErrorString(e), grid);
}
```

```cpp
#include <hip/hip_runtime.h>
#include <hip/hip_cooperative_groups.h>
#include <cstdio>
#include <cstdint>
namespace cg = cooperative_groups;

#define LAS __attribute__((address_space(3)))
typedef unsigned short bf16_t;
typedef short bf16x8 __attribute__((ext_vector_type(8)));
typedef short s16x4 __attribute__((ext_vector_type(4)));
typedef float f32x4 __attribute__((ext_vector_type(4)));
typedef float f32x16 __attribute__((ext_vector_type(16)));
typedef unsigned u32x4 __attribute__((ext_vector_type(4)));
typedef unsigned u32x2 __attribute__((ext_vector_type(2)));

constexpr int NTHR = 512;
constexpr int BATCH = 8, SEQ = 2048, DM = 1024, MTOK = BATCH * SEQ, NMEM = 256, MMEM = BATCH * NMEM, DFF = 4096, INC = 1792;
constexpr float LN_EPS = 1e-5f;
constexpr float ALPHA = 1.189207115002721f;
constexpr int LDS_MAIN = 131072;
constexpr int LDS_BYTES = LDS_MAIN + 16;

constexpr size_t MiB = 1024 * 1024;
constexpr size_t OFF_WIN = 0;
constexpr size_t OFF_WOUT = OFF_WIN + (size_t)INC * DM * 2;
constexpr size_t OFF_WMQ = OFF_WOUT + (size_t)DM * DM * 2;
constexpr size_t OFF_WMKV = OFF_WMQ + (size_t)DM * DM * 2;
constexpr size_t OFF_WMO = OFF_WMKV + (size_t)2 * DM * DM * 2;
constexpr size_t OFF_WFF1 = OFF_WMO + (size_t)DM * DM * 2;
constexpr size_t OFF_WFF2 = OFF_WFF1 + (size_t)DFF * DM * 2;
constexpr size_t OFF_A = OFF_WFF2 + (size_t)DFF * DM * 2;
constexpr size_t OFF_B = OFF_A + 64 * MiB;
constexpr size_t OFF_REST = OFF_B + 32 * MiB;
constexpr size_t OFF_MEMB = OFF_REST;
constexpr size_t OFF_MEMK = OFF_REST + 4 * MiB;
constexpr size_t OFF_MEMVT = OFF_REST + 8 * MiB;
constexpr size_t OFF_T = OFF_REST + 12 * MiB;
constexpr size_t OFF_U = OFF_T + 24 * MiB;
constexpr size_t OFF_Y = OFF_T + 64 * MiB;
constexpr size_t OFF_Q = OFF_Y + 32 * MiB;
constexpr size_t OFF_KR = OFF_Q + 16 * MiB;
constexpr size_t OFF_A1 = OFF_REST;
constexpr size_t OFF_SMALL = OFF_REST + 128 * MiB;
constexpr size_t OFF_BAR = OFF_SMALL + 128 * 1024;
constexpr size_t BAR_BYTES = 16384;
constexpr size_t OFF_TS = OFF_BAR + BAR_BYTES;
constexpr size_t WS_END = OFF_TS + 1024;
constexpr int SM_QG = 0, SM_KG = 64, SM_CONVW = 128, SM_CONVB = SM_CONVW + 31 * 512, SM_CLNG = SM_CONVB + 512, SM_CLNB = SM_CLNG + 512,
              SM_AOG = SM_CLNB + 512, SM_COG = SM_AOG + 512, SM_LN1G = SM_COG + 512, SM_LN1B = SM_LN1G + 1024, SM_LN2G = SM_LN1B + 1024,
              SM_LN2B = SM_LN2G + 1024, SM_BFF1 = SM_LN2B + 1024, SM_BFF2 = SM_BFF1 + 4096, SM_LN3G = SM_BFF2 + 1024, SM_LN3B = SM_LN3G + 1024,
              SM_END = SM_LN3B + 1024;
static_assert(SM_END * 4 <= 128 * 1024, "small block");

struct Params {
    const float* in[27];
    float* out;
    unsigned char* ws;
    int ph_lo, ph_hi;
};

__device__ __forceinline__ unsigned cvt_pk_bf16(float lo, float hi) { unsigned r; asm volatile("v_cvt_pk_bf16_f32 %0, %1, %2" : "=v"(r) : "v"(lo), "v"(hi)); return r; }
__device__ __forceinline__ float bf2f(unsigned short b) { return __uint_as_float(((unsigned)b) << 16); }
__device__ __forceinline__ float bflo(unsigned w) { return __uint_as_float(w << 16); }
__device__ __forceinline__ float bfhi(unsigned w) { return __uint_as_float(w & 0xffff0000u); }
template <int CTRL> __device__ __forceinline__ float dpp_f(float v) { return __int_as_float(__builtin_amdgcn_update_dpp(0, __float_as_int(v), CTRL, 0xF, 0xF, true)); }
__device__ __forceinline__ float rdlane(float v, int l) { return __int_as_float(__builtin_amdgcn_readlane(__float_as_int(v), l)); }
__device__ __forceinline__ float sum8(float v) { v += dpp_f<0xB1>(v); v += dpp_f<0x4E>(v); v += dpp_f<0x141>(v); return v; }
__device__ __forceinline__ float sum16(float v) { v = sum8(v); v += dpp_f<0x140>(v); return v; }
__device__ __forceinline__ float wave_sum(float v) { v = sum16(v); return (rdlane(v, 0) + rdlane(v, 16)) + (rdlane(v, 32) + rdlane(v, 48)); }
__device__ __forceinline__ float wave_max(float v) {
    v = fmaxf(v, dpp_f<0xB1>(v)); v = fmaxf(v, dpp_f<0x4E>(v)); v = fmaxf(v, dpp_f<0x141>(v)); v = fmaxf(v, dpp_f<0x140>(v));
    return fmaxf(fmaxf(rdlane(v, 0), rdlane(v, 16)), fmaxf(rdlane(v, 32), rdlane(v, 48)));
}
__device__ __forceinline__ int otid() { int t = threadIdx.x; asm volatile("" : "+v"(t)); return t; }
__device__ __forceinline__ int obid() { int t = blockIdx.x; asm volatile("" : "+s"(t)); return t; }
__device__ __forceinline__ int ogrid() { int t = gridDim.x; asm volatile("" : "+s"(t)); return t; }
__device__ __forceinline__ float sigmoidf_(float x) { return __builtin_amdgcn_rcpf(1.f + __expf(-x)); }


#define XB_TMO      128
#define XB_XCNT(j)  (256  + 64 * (j))
#define XB_XSUB(j)  (1280 + 64 * (j))
#define XB_XGEN(j)  (2304 + 64 * (j))
#define XB_TOP      3328
#define XB_TOPGEN   3392
#define XCD_BAR_WORDS 3456
#define XB_SPIN_CAP (1u << 22)
static_assert(XCD_BAR_WORDS * 4 <= BAR_BYTES, "barrier words");
__device__ __forceinline__ unsigned xb_ld(unsigned* p)              { return __hip_atomic_load(p, __ATOMIC_RELAXED, __HIP_MEMORY_SCOPE_AGENT); }
__device__ __forceinline__ unsigned xb_add(unsigned* p, unsigned v) { return __hip_atomic_fetch_add(p, v, __ATOMIC_RELAXED, __HIP_MEMORY_SCOPE_AGENT); }
__device__ __forceinline__ unsigned xb_xcc_id() { return (unsigned)__builtin_amdgcn_s_getreg((3 << 11) | 20) & 0xFu; }
#define XB_SPIN(cond, bar) do { unsigned _sp = 0; while (cond) { __builtin_amdgcn_s_sleep(1); \
    if ((++_sp & 255u) == 0u) { if (xb_ld(&(bar)[XB_TMO])) break; if (_sp > XB_SPIN_CAP) { atomicAdd(&(bar)[XB_TMO], 1u); break; } } } } while (0)
struct XcdBarrier { unsigned* bar; unsigned x; volatile LAS unsigned* st; };
__device__ __forceinline__ XcdBarrier xcd_barrier_post(unsigned* bar, volatile LAS unsigned* st) {
    XcdBarrier b; b.bar = bar; b.x = xb_xcc_id(); b.st = st;
    if (threadIdx.x == 0) (void)xb_add(&bar[XB_XCNT(b.x)], 1u);
    return b;
}
__device__ __forceinline__ void xcd_barrier_complete(unsigned* bar, unsigned x, unsigned& nloc, unsigned& nx) {
    const unsigned G = gridDim.x * gridDim.y * gridDim.z;
    unsigned sum, cnt, mine, sp = 0u;
    for (;;) {
        sum = 0u; cnt = 0u; mine = 0u;
#pragma unroll
        for (unsigned j = 0; j < 16; ++j) { const unsigned c = xb_ld(&bar[XB_XCNT(j)]); sum += c; cnt += (c > 0u) ? 1u : 0u; mine = (j == x) ? c : mine; }
        if (sum == G) break;
        __builtin_amdgcn_s_sleep(1);
        if ((++sp & 255u) == 0u) { if (xb_ld(&bar[XB_TMO])) break; if (sp > XB_SPIN_CAP) { atomicAdd(&bar[XB_TMO], 1u); break; } }
    }
    nloc = mine > 0u ? mine : 1u; nx = cnt > 0u ? cnt : 1u;
}
__device__ __forceinline__ void xcd_barrier(const XcdBarrier& b) {
    asm volatile("s_waitcnt vmcnt(0)" ::: "memory");
    __syncthreads();
    if (threadIdx.x == 0) {
        unsigned* bar = b.bar;
        __builtin_amdgcn_s_waitcnt(0);
        unsigned nloc = b.st[0], nx = b.st[1];
        if (nloc == 0u) { xcd_barrier_complete(bar, b.x, nloc, nx); b.st[0] = nloc; b.st[1] = nx; }
        const unsigned old = xb_add(&bar[XB_XSUB(b.x)], 1u);
        const unsigned gen = old / nloc;
        if (old + 1u == (gen + 1u) * nloc) {
            __builtin_amdgcn_fence(__ATOMIC_RELEASE, "agent");
            asm volatile("s_waitcnt vmcnt(0)" ::: "memory");
            const unsigned og = xb_add(&bar[XB_TOP], 1u);
            const unsigned tg = og / nx;
            if (og + 1u == (tg + 1u) * nx) xb_add(&bar[XB_TOPGEN], 1u);
            else XB_SPIN(xb_ld(&bar[XB_TOPGEN]) == tg, bar);
            __builtin_amdgcn_fence(__ATOMIC_ACQUIRE, "agent");
            xb_add(&bar[XB_XGEN(b.x)], 1u);
            asm volatile("s_waitcnt vmcnt(0)" ::: "memory");
        } else {
            XB_SPIN(xb_ld(&bar[XB_XGEN(b.x)]) == gen, bar);
            __builtin_amdgcn_fence(__ATOMIC_ACQUIRE, "agent");
            asm volatile("s_waitcnt vmcnt(0)" ::: "memory");
        }
    }
    __syncthreads();
}

constexpr int BM = 256, BK = 64, HALF = 128, HTB = HALF * BK * 2, NXCD = 8, WGM = 8;

__device__ __forceinline__ int lds_byte(int r, int c) { const int st = (r >> 4) * 2 + (c >> 5), rr = r & 15, cc = c & 31, ob = rr * 64 + cc * 2; return st * 1024 + (ob ^ (((ob >> 9) & 1) << 5)); }
__device__ __forceinline__ void stage_rc(int b, int& R, int& C) { const int st = b / 1024, sb = b % 1024, swz = sb ^ (((sb >> 9) & 1) << 5); R = (st >> 1) * 16 + swz / 64; C = (st & 1) * 32 + (swz % 64) / 2; }
__device__ __forceinline__ int perm32(int rho) { const int n = rho >> 4, i = rho & 15; return 8 * (i >> 2) + 4 * n + (i & 3); }

struct GemmDesc {
    const bf16_t* A; const bf16_t* Bt; int lda, ldb, K;
    int nM, nN, nZ, zdiv;
    long sA0, sA1, sB0, sB1;
    int rz0, cz1;
    int shift;
    int kind;
    void* out; void* out2; int ldc; const float* bias; float scale; int act; float alpha;
};
struct Unit { const char* a; const char* b; int row0, col0; };

__device__ __forceinline__ bool next_unit(const GemmDesc& d, int i, int G, int c, Unit& u) {
    const int per = d.nM * d.nN; const long L = (long)i * G + c;
    if (L >= (long)per * d.nZ) return false;
    const int z = (int)(L / per); int w = (int)(L % per); int pm, pn;
    if (d.nZ == 1) {
        const int nwg = per; const int q = nwg / NXCD, r = nwg % NXCD, xcd = w % NXCD, off = w / NXCD;
        w = (xcd < r ? xcd * (q + 1) : r * (q + 1) + (xcd - r) * q) + off;
        const int nig = WGM * d.nN, gid = w / nig, fm = gid * WGM, gsz = (d.nM - fm) < WGM ? (d.nM - fm) : WGM;
        pm = fm + ((w % nig) % gsz); pn = (w % nig) / gsz;
    } else { pm = w % d.nM; pn = w / d.nM; }
    const int z0 = z / d.zdiv, z1 = z % d.zdiv;
    u.a = (const char*)(d.A + (long)z0 * d.sA0 + (long)z1 * d.sA1 + (long)pm * BM * d.lda);
    u.b = (const char*)(d.Bt + (long)z0 * d.sB0 + (long)z1 * d.sB1 + (long)pn * BM * d.ldb);
    u.row0 = z0 * d.rz0 + pm * BM; u.col0 = z1 * d.cz1 + pn * BM;
    return true;
}

__device__ __forceinline__ void gemm_epilogue(const f32x4 (&acc)[2][2][4][2], const GemmDesc& d, const Unit& u, int wr, int wc, int fr, int fq) {
    const int row0 = u.row0 + wr * 64 + fr, col0 = u.col0 + wc * 32 + 8 * fq;
    f32x4 bv[2][2];
#pragma unroll
    for (int bj = 0; bj < 2; ++bj)
#pragma unroll
        for (int n = 0; n < 2; ++n) bv[bj][n] = d.bias ? *(const f32x4*)(d.bias + col0 + bj * HALF + 4 * n) : (f32x4){0.f, 0.f, 0.f, 0.f};
    const float sc = d.scale;
    if (d.kind == 2 && u.col0 >= 768) {
        bf16_t* O = (bf16_t*)d.out2; const int ucol = ((u.col0 - 768) >> 1) + wc * 32 + 8 * fq;
#pragma unroll
        for (int ai = 0; ai < 2; ++ai)
#pragma unroll
            for (int m = 0; m < 4; ++m) {
                f32x4 v0 = acc[ai][0][m][0], v1 = acc[ai][0][m][1]; const f32x4 g0 = acc[ai][1][m][0], g1 = acc[ai][1][m][1];
#pragma unroll
                for (int j = 0; j < 4; ++j) { v0[j] *= sigmoidf_(g0[j]); v1[j] *= sigmoidf_(g1[j]); }
                u32x4 w; w.x = cvt_pk_bf16(v0[0], v0[1]); w.y = cvt_pk_bf16(v0[2], v0[3]); w.z = cvt_pk_bf16(v1[0], v1[1]); w.w = cvt_pk_bf16(v1[2], v1[3]);
                *(u32x4*)(O + (size_t)(row0 + ai * HALF + m * 16) * 512 + ucol) = w;
            }
        return;
    }
    if (d.kind != 1) {
        bf16_t* O = (bf16_t*)d.out;
#pragma unroll
        for (int ai = 0; ai < 2; ++ai)
#pragma unroll
            for (int m = 0; m < 4; ++m) {
                bf16_t* rowp = O + (size_t)(row0 + ai * HALF + m * 16) * d.ldc + col0;
#pragma unroll
                for (int bj = 0; bj < 2; ++bj) {
                    f32x4 v0 = acc[ai][bj][m][0] * sc + bv[bj][0], v1 = acc[ai][bj][m][1] * sc + bv[bj][1];
                    if (d.act == 1) {
#pragma unroll
                        for (int j = 0; j < 4; ++j) { float a = fmaxf(v0[j], 0.f), b = fmaxf(v1[j], 0.f); v0[j] = a * a; v1[j] = b * b; }
                    }
                    u32x4 w; w.x = cvt_pk_bf16(v0[0], v0[1]); w.y = cvt_pk_bf16(v0[2], v0[3]); w.z = cvt_pk_bf16(v1[0], v1[1]); w.w = cvt_pk_bf16(v1[2], v1[3]);
                    *(u32x4*)(rowp + bj * HALF) = w;
                }
            }
    } else {
        float* C = (float*)d.out; const float al = d.alpha;
#pragma unroll
        for (int ai = 0; ai < 2; ++ai)
#pragma unroll
            for (int m = 0; m < 4; ++m) {
                float* rowp = C + (size_t)(row0 + ai * HALF + m * 16) * d.ldc + col0;
#pragma unroll
                for (int bj = 0; bj < 2; ++bj) {
                    f32x4 v0 = acc[ai][bj][m][0] * sc + bv[bj][0], v1 = acc[ai][bj][m][1] * sc + bv[bj][1];
                    if (al != 0.f) { const f32x4 o0 = *(const f32x4*)(rowp + bj * HALF), o1 = *(const f32x4*)(rowp + bj * HALF + 4); v0 += o0 * al; v1 += o1 * al; }
                    *(f32x4*)(rowp + bj * HALF) = v0; *(f32x4*)(rowp + bj * HALF + 4) = v1;
                }
            }
    }
}

__device__ __forceinline__ void gemm_phase(LAS unsigned char* lds, const GemmDesc& d) {
    const int tid = otid(), wid = __builtin_amdgcn_readfirstlane(tid >> 6), lane = tid & 63, wr = wid >> 2, wc = wid & 3, fr = lane & 15, fq = lane >> 4;
    const int G = ogrid(); int cblk = obid() - d.shift; if (cblk < 0) cblk += G;
    const int K = d.K, nt = K / BK;
    unsigned voffA[2], voffB[2];
#pragma unroll
    for (int i = 0; i < 2; ++i) { int R, C; stage_rc(tid * 16 + i * 8192, R, C); const int Rb = (R & ~31) + perm32(R & 31);
        voffA[i] = (unsigned)(R * d.lda + C) * 2u; voffB[i] = (unsigned)(Rb * d.ldb + C) * 2u; }
    const size_t kstep = (size_t)(BK * 2);
    const size_t hstepA = (size_t)HALF * d.lda * 2, hstepB = (size_t)HALF * d.ldb * 2;
    const unsigned ldsw = (unsigned)wid * 1024u;
    const int aoff = lds_byte(wr * 64 + fr, fq * 8), boff = lds_byte(wc * 32 + fr, fq * 8);
#define PG8_SA(b, h) (((b) * 2 + (h)) * HTB)
#define PG8_SB(b, h) ((4 + (b) * 2 + (h)) * HTB)
#define PG8_STAGE(bufoff, gbase, voff) do { _Pragma("unroll") for (int _i = 0; _i < 2; ++_i) \
        __builtin_amdgcn_global_load_lds((const unsigned*)((const char*)(gbase) + (voff)[_i]), (LAS unsigned*)(lds + (bufoff) + ldsw + _i * 8192), 16, 0, 0); } while (0)
#define PG8_LDA(dst, b, h) do { _Pragma("unroll") for (int m = 0; m < 4; ++m) _Pragma("unroll") for (int k = 0; k < 2; ++k) dst[m][k] = *(const LAS bf16x8*)(lds + PG8_SA(b, h) + aoff + m * 2048 + k * 1024); } while (0)
#define PG8_LDB(dst, b, h) do { _Pragma("unroll") for (int n = 0; n < 2; ++n) _Pragma("unroll") for (int k = 0; k < 2; ++k) dst[n][k] = *(const LAS bf16x8*)(lds + PG8_SB(b, h) + boff + n * 2048 + k * 1024); } while (0)
#define PG8_MMA(ai, bj, At, Bt) do { __builtin_amdgcn_s_setprio(1); _Pragma("unroll") for (int m = 0; m < 4; ++m) _Pragma("unroll") for (int n = 0; n < 2; ++n) _Pragma("unroll") for (int k = 0; k < 2; ++k) \
        acc[ai][bj][m][n] = __builtin_amdgcn_mfma_f32_16x16x32_bf16(Bt[n][k], At[m][k], acc[ai][bj][m][n], 0, 0, 0); __builtin_amdgcn_s_setprio(0); } while (0)
#define PG8_WAIT_V(n) asm volatile("s_waitcnt vmcnt(" #n ")" ::: "memory")
#define PG8_WAIT_L(n) asm volatile("s_waitcnt lgkmcnt(" #n ")" ::: "memory")
#define PG8_BAR __builtin_amdgcn_s_barrier()
#define PG8_SCHED __builtin_amdgcn_sched_barrier(0)
    Unit cur, nxt; int ui = 0;
    if (!next_unit(d, 0, G, cblk, cur)) return;
    f32x4 acc[2][2][4][2];
#pragma unroll
    for (int a = 0; a < 2; ++a)
#pragma unroll
        for (int b = 0; b < 2; ++b)
#pragma unroll
            for (int m = 0; m < 4; ++m)
#pragma unroll
                for (int n = 0; n < 2; ++n) acc[a][b][m][n] = (f32x4){0.f, 0.f, 0.f, 0.f};
    bf16x8 At[4][2], B0[2][2], B1[2][2];
    const char* cA = cur.a; const char* cB = cur.b;
    PG8_STAGE(PG8_SB(0, 0), cB, voffB); PG8_STAGE(PG8_SA(0, 0), cA, voffA); PG8_STAGE(PG8_SB(0, 1), cB + hstepB, voffB); PG8_STAGE(PG8_SA(0, 1), cA + hstepA, voffA);
    if (wr == 1) PG8_BAR;
    PG8_WAIT_V(4); PG8_BAR;
    PG8_STAGE(PG8_SB(1, 0), cB + kstep, voffB); PG8_STAGE(PG8_SA(1, 0), cA + kstep, voffA); PG8_STAGE(PG8_SB(1, 1), cB + hstepB + kstep, voffB);
    PG8_WAIT_V(6); PG8_BAR;
    for (;;) {
        const bool has_next = next_unit(d, ui + 1, G, cblk, nxt);
        const char* nA = has_next ? nxt.a : cA; const char* nB = has_next ? nxt.b : cB;
        for (int t = 0; t < nt; t += 2) {
            const bool last = (t == nt - 2);
            const char* a1 = cA + (size_t)(t + 1) * kstep;
            const char* a2 = last ? nA : cA + (size_t)(t + 2) * kstep; const char* b2 = last ? nB : cB + (size_t)(t + 2) * kstep;
            const char* a3 = a2 + kstep; const char* b3 = b2 + kstep;
            PG8_LDB(B0, 0, 0); PG8_SCHED; PG8_LDA(At, 0, 0); PG8_STAGE(PG8_SA(1, 1), a1 + hstepA, voffA);
            PG8_WAIT_L(8); PG8_BAR; PG8_WAIT_L(0); PG8_MMA(0, 0, At, B0); PG8_BAR; PG8_SCHED;
            PG8_LDB(B1, 0, 1); PG8_STAGE(PG8_SB(0, 0), b2, voffB);
            PG8_BAR; PG8_WAIT_L(0); PG8_MMA(0, 1, At, B1); PG8_BAR;
            PG8_LDA(At, 0, 1); PG8_STAGE(PG8_SA(0, 0), a2, voffA);
            PG8_BAR; PG8_WAIT_L(0); PG8_MMA(1, 0, At, B0); PG8_BAR; PG8_SCHED;
            PG8_STAGE(PG8_SB(0, 1), b2 + hstepB, voffB);
            PG8_WAIT_V(6); PG8_BAR; PG8_MMA(1, 1, At, B1); PG8_BAR;
            PG8_LDB(B0, 1, 0); PG8_SCHED; PG8_LDA(At, 1, 0); PG8_STAGE(PG8_SA(0, 1), a2 + hstepA, voffA);
            PG8_WAIT_L(8); PG8_BAR; PG8_WAIT_L(0); PG8_MMA(0, 0, At, B0); PG8_BAR; PG8_SCHED;
            PG8_LDB(B1, 1, 1); PG8_STAGE(PG8_SB(1, 0), b3, voffB);
            PG8_BAR; PG8_WAIT_L(0); PG8_MMA(0, 1, At, B1); PG8_BAR;
            PG8_LDA(At, 1, 1); PG8_STAGE(PG8_SA(1, 0), a3, voffA);
            PG8_BAR; PG8_WAIT_L(0); PG8_MMA(1, 0, At, B0); PG8_BAR; PG8_SCHED;
            PG8_STAGE(PG8_SB(1, 1), b3 + hstepB, voffB);
            PG8_WAIT_V(6); PG8_BAR; PG8_MMA(1, 1, At, B1); PG8_BAR;
        }
        gemm_epilogue(acc, d, cur, wr, wc, fr, fq);
        if (!has_next) break;
#pragma unroll
        for (int a = 0; a < 2; ++a)
#pragma unroll
            for (int b = 0; b < 2; ++b)
#pragma unroll
                for (int m = 0; m < 4; ++m)
#pragma unroll
                    for (int n = 0; n < 2; ++n) acc[a][b][m][n] = (f32x4){0.f, 0.f, 0.f, 0.f};
        cur = nxt; cA = nA; cB = nB; ++ui;
    }
    PG8_WAIT_V(0);
    if (wr == 0) PG8_BAR;
    PG8_BAR;
#undef PG8_SA
#undef PG8_SB
#undef PG8_STAGE
#undef PG8_LDA
#undef PG8_LDB
#undef PG8_MMA
#undef PG8_WAIT_V
#undef PG8_WAIT_L
#undef PG8_BAR
#undef PG8_SCHED
}

namespace att {
constexpr int D = 64, NW = 8, QBLK = 32, KVBLK = 64;
constexpr float SCALE = 0.125f, THR = 8.f;
constexpr int SHM_V = KVBLK * D * 2, SHM_K = KVBLK * D * 2;
constexpr int LDQ = 512, LDK = 128, LDV = 768, LDY = DM;
#define KSWZ(row, colB) ((row) * 128 + ((colB) ^ ((((row) >> 1) & 7) << 4)))
#define SBAR() __builtin_amdgcn_sched_barrier(0)
__device__ __forceinline__ int crow(int r, int hi) { return (r & 3) + 8 * (r >> 2) + 4 * hi; }

__device__ __forceinline__ void partialSM(f32x16& p0, f32x16& p1, float& m_reg, float& mn, float& alpha) {
    constexpr float C = SCALE * 1.4426950408889634f;
    float pmax = p0[0];
#pragma unroll
    for (int r = 1; r < 16; ++r) pmax = fmaxf(pmax, p0[r]);
#pragma unroll
    for (int r = 0; r < 16; ++r) pmax = fmaxf(pmax, p1[r]);
    { auto rr = __builtin_amdgcn_permlane32_swap(__float_as_uint(pmax), __float_as_uint(pmax), false, false);
      pmax = fmaxf(__uint_as_float(rr[0]), __uint_as_float(rr[1])); }
    if (__builtin_expect(__all(pmax - m_reg <= THR / SCALE), 1)) { mn = m_reg; alpha = 1.f; }
    else { mn = fmaxf(m_reg, pmax); alpha = __builtin_amdgcn_exp2f((m_reg - mn) * C); m_reg = mn; }
    const float mnC = -mn * C;
#pragma unroll
    for (int r = 0; r < 16; ++r) p0[r] = fmaf(p0[r], C, mnC);
#pragma unroll
    for (int r = 0; r < 16; ++r) p1[r] = fmaf(p1[r], C, mnC);
#pragma unroll
    for (int r = 0; r < 16; ++r) p0[r] = __builtin_amdgcn_exp2f(p0[r]);
}
__device__ __forceinline__ void finishSM(f32x16& p0, f32x16& p1, float alpha, float& l_reg, bf16x8& pa0, bf16x8& pa1, bf16x8& pa2, bf16x8& pa3) {
#pragma unroll
    for (int r = 0; r < 16; ++r) p1[r] = __builtin_amdgcn_exp2f(p1[r]);
    float ps = 0;
#pragma unroll
    for (int r = 0; r < 16; ++r) ps += p0[r];
#pragma unroll
    for (int r = 0; r < 16; ++r) ps += p1[r];
    { auto rr = __builtin_amdgcn_permlane32_swap(__float_as_uint(ps), __float_as_uint(ps), false, false);
      ps = __uint_as_float(rr[0]) + __uint_as_float(rr[1]); }
    l_reg = l_reg * alpha + ps;
#define PK4(P, BASE, OUT) do { unsigned a0 = cvt_pk_bf16(P[BASE + 0], P[BASE + 1]), a1 = cvt_pk_bf16(P[BASE + 2], P[BASE + 3]);   \
    unsigned b0 = cvt_pk_bf16(P[BASE + 4], P[BASE + 5]), b1 = cvt_pk_bf16(P[BASE + 6], P[BASE + 7]);                              \
    auto r0 = __builtin_amdgcn_permlane32_swap(a0, b0, false, false); auto r1 = __builtin_amdgcn_permlane32_swap(a1, b1, false, false); \
    u32x4 w = {r0[0], r1[0], r0[1], r1[1]}; OUT = *reinterpret_cast<bf16x8*>(&w); } while (0)
    PK4(p0, 0, pa0); PK4(p0, 8, pa1); PK4(p1, 0, pa2); PK4(p1, 8, pa3);
#undef PK4
}
__device__ __forceinline__ void qkt(f32x16& p0, f32x16& p1, const char* Ks, const bf16x8* qr, int r32, int hi) {
    p0 = f32x16{}; p1 = f32x16{};
#pragma unroll
    for (int d0 = 0; d0 < 4; ++d0) { const int cb = (d0 * 16 + hi * 8) * 2;
        bf16x8 b0 = *reinterpret_cast<const bf16x8*>(Ks + KSWZ(r32, cb));
        bf16x8 b1 = *reinterpret_cast<const bf16x8*>(Ks + KSWZ(32 + r32, cb));
        p0 = __builtin_amdgcn_mfma_f32_32x32x16_bf16(b0, qr[d0], p0, 0, 0, 0);
        p1 = __builtin_amdgcn_mfma_f32_32x32x16_bf16(b1, qr[d0], p1, 0, 0, 0); }
}
__device__ __forceinline__ int v_st(int k, int c) { const int kk = (k & ~0xC) | ((k & 4) << 1) | ((k & 8) >> 1); return ((kk >> 3) * 2 + (c >> 5)) * 512 + ((kk & 7) * 32 + (c & 31)) * 2; }
__device__ __forceinline__ int v_rd_base(int lane) { return ((lane & 3) << 3) | (((lane >> 2) & 3) << 6) | (((lane >> 4) & 1) << 5) | (((lane >> 5) & 1) << 8); }
constexpr int v_rd_off(int d0, int ks, int half) { return d0 * 512 + ks * 2048 + half * 1024; }
template <int OFF> __device__ __forceinline__ s16x4 tr_read(int vb) {
    s16x4 r; asm volatile("ds_read_b64_tr_b16 %0, %1 offset:%2" : "=&v"(r) : "v"(vb), "i"(OFF) : "memory"); return r;
}
template <int D0> __device__ __forceinline__ void pv_one(f32x16& od, int vb, bf16x8 pa0, bf16x8 pa1, bf16x8 pa2, bf16x8 pa3) {
    const s16x4 l0 = tr_read<v_rd_off(D0, 0, 0)>(vb), h0 = tr_read<v_rd_off(D0, 0, 1)>(vb), l1 = tr_read<v_rd_off(D0, 1, 0)>(vb), h1 = tr_read<v_rd_off(D0, 1, 1)>(vb);
    const s16x4 l2 = tr_read<v_rd_off(D0, 2, 0)>(vb), h2 = tr_read<v_rd_off(D0, 2, 1)>(vb), l3 = tr_read<v_rd_off(D0, 3, 0)>(vb), h3 = tr_read<v_rd_off(D0, 3, 1)>(vb);
    asm volatile("s_waitcnt lgkmcnt(0)" ::: "memory"); SBAR();
#define PK(L, H) (bf16x8){L[0], L[1], L[2], L[3], H[0], H[1], H[2], H[3]}
    od = __builtin_amdgcn_mfma_f32_32x32x16_bf16(pa0, PK(l0, h0), od, 0, 0, 0);
    od = __builtin_amdgcn_mfma_f32_32x32x16_bf16(pa1, PK(l1, h1), od, 0, 0, 0);
    od = __builtin_amdgcn_mfma_f32_32x32x16_bf16(pa2, PK(l2, h2), od, 0, 0, 0);
    od = __builtin_amdgcn_mfma_f32_32x32x16_bf16(pa3, PK(l3, h3), od, 0, 0, 0);
#undef PK
}
__device__ __forceinline__ void pv_d0(f32x16* o, int vb, bf16x8 pa0, bf16x8 pa1, bf16x8 pa2, bf16x8 pa3) {
    pv_one<0>(o[0], vb, pa0, pa1, pa2, pa3); pv_one<1>(o[1], vb, pa0, pa1, pa2, pa3);
}

__device__ __forceinline__ void attn_body(const bf16_t* __restrict__ Qb, const bf16_t* __restrict__ Kh, const bf16_t* __restrict__ Vh,
                                          bf16_t* __restrict__ Yb, const float* __restrict__ gain, int seq, char* lds) {
    const int tid = otid(), wid = tid >> 6, lane = tid & 63, r32 = lane & 31, hi = lane >> 5;
    char* V_lds = lds; char* K_lds = lds + 2 * SHM_V;
    float* ws = (float*)(lds + 2 * SHM_V + 2 * SHM_K) + wid * 64; float* li_l = ws; float* al_l = ws + 32;
    float m_reg = -1e30f, l_reg = 0; f32x16 o[2] = {}; bf16x8 qr[4];
    const bf16_t* Qw = Qb + (long)(wid * QBLK + r32) * LDQ + hi * 8;
#pragma unroll
    for (int d0 = 0; d0 < 4; ++d0) qr[d0] = *reinterpret_cast<const bf16x8*>(Qw + d0 * 16);
    const int sr = tid >> 3, sc = (tid & 7) * 8, vst0 = v_st(sr, sc), kst0 = KSWZ(sr, sc * 2);
    const int vb0 = (int)(uintptr_t)V_lds + v_rd_base(lane);
    bf16x8 vsE, ksE, vsO, ksO;
#define SLOADE(k0) do { vsE = *reinterpret_cast<const bf16x8*>(&Vh[(long)((k0) + sr) * LDV + sc]); ksE = *reinterpret_cast<const bf16x8*>(&Kh[(long)((k0) + sr) * LDK + sc]); } while (0)
#define SLOADO(k0) do { vsO = *reinterpret_cast<const bf16x8*>(&Vh[(long)((k0) + sr) * LDV + sc]); ksO = *reinterpret_cast<const bf16x8*>(&Kh[(long)((k0) + sr) * LDK + sc]); } while (0)
#define SWRITEE(b) do { *(bf16x8*)(V_lds + (b) * SHM_V + vst0) = vsE; *(bf16x8*)(K_lds + (b) * SHM_K + kst0) = ksE; } while (0)
#define SWRITEO(b) do { *(bf16x8*)(V_lds + (b) * SHM_V + vst0) = vsO; *(bf16x8*)(K_lds + (b) * SHM_K + kst0) = ksO; } while (0)
#define SWAIT() asm volatile("s_waitcnt vmcnt(2)" ::: "memory")
#define RESC(a) do { if (__any((a) < 1.f)) { if (hi == 0) al_l[r32] = (a); asm volatile("s_waitcnt lgkmcnt(0)" ::: "memory"); \
    _Pragma("unroll") for (int dd = 0; dd < 2; ++dd) _Pragma("unroll") for (int r = 0; r < 16; ++r) o[dd][r] *= al_l[crow(r, hi)]; } } while (0)
    f32x16 pA0, pA1, pB0, pB1; float mnA, mnB, alA, alB; bf16x8 pa0, pa1, pa2, pa3; const int NTL = seq / KVBLK;
    SLOADE(0); asm volatile("s_waitcnt vmcnt(0)" ::: "memory"); SWRITEE(0); __syncthreads();
    qkt(pA0, pA1, K_lds, qr, r32, hi); partialSM(pA0, pA1, m_reg, mnA, alA);
    SLOADO(KVBLK); if (2 < NTL) SLOADE(2 * KVBLK);
    SWAIT(); SWRITEO(1); __syncthreads();
    for (int j = 1; j + 1 < NTL; j += 2) {
        SBAR(); qkt(pB0, pB1, K_lds + SHM_K, qr, r32, hi);
        finishSM(pA0, pA1, alA, l_reg, pa0, pa1, pa2, pa3); SBAR();
        SLOADO((j + 2) * KVBLK); SBAR();
        pv_d0(o, vb0, pa0, pa1, pa2, pa3); partialSM(pB0, pB1, m_reg, mnB, alB);
        __syncthreads(); SWAIT(); SWRITEE(0);
        RESC(alB); __syncthreads();
        SBAR(); qkt(pA0, pA1, K_lds, qr, r32, hi);
        finishSM(pB0, pB1, alB, l_reg, pa0, pa1, pa2, pa3); SBAR();
        if (j + 3 < NTL) SLOADE((j + 3) * KVBLK); SBAR();
        pv_d0(o, vb0 + SHM_V, pa0, pa1, pa2, pa3); partialSM(pA0, pA1, m_reg, mnA, alA);
        __syncthreads(); SWAIT(); SWRITEO(1);
        RESC(alA); __syncthreads();
    }
    SBAR(); qkt(pB0, pB1, K_lds + SHM_K, qr, r32, hi);
    finishSM(pA0, pA1, alA, l_reg, pa0, pa1, pa2, pa3); SBAR();
    pv_d0(o, vb0, pa0, pa1, pa2, pa3); partialSM(pB0, pB1, m_reg, mnB, alB);
    __syncthreads(); RESC(alB);
    finishSM(pB0, pB1, alB, l_reg, pa0, pa1, pa2, pa3); SBAR();
    pv_d0(o, vb0 + SHM_V, pa0, pa1, pa2, pa3);
    if (hi == 0) li_l[r32] = l_reg; asm volatile("s_waitcnt lgkmcnt(0)" ::: "memory");
    const float g0 = gain[r32], g1 = gain[32 + r32];
    bf16_t* Yw = Yb + (long)(wid * QBLK) * LDY;
#pragma unroll
    for (int r = 0; r < 16; ++r) {
        const int orow = crow(r, hi);
        const float rl = __builtin_amdgcn_rcpf(li_l[orow]);
        const float a = o[0][r] * rl, b = o[1][r] * rl;
        float ss = a * a + b * b;
        ss = sum16(ss); ss += __shfl_xor(ss, 16);
        const float rs = rsqrtf(ss * (1.f / 64.f) + LN_EPS);
        const unsigned wa = cvt_pk_bf16(a * rs * g0, b * rs * g1);
        Yw[(long)orow * LDY + r32] = (bf16_t)(wa & 0xffffu);
        Yw[(long)orow * LDY + 32 + r32] = (bf16_t)(wa >> 16);
    }
    __syncthreads();
#undef SLOADE
#undef SLOADO
#undef SWRITEE
#undef SWRITEO
#undef SWAIT
#undef RESC
}
}

__device__ __forceinline__ void ln_rows(const float* src, float* dstf, bf16_t* dstb, const float* __restrict__ g, const float* __restrict__ b) {
    const int tid = otid(), lane = tid & 63, wid = tid >> 6;
    const int nw = ogrid() * 8;
    f32x4 gv[4], bv[4];
#pragma unroll
    for (int j = 0; j < 4; ++j) { gv[j] = *(const f32x4*)(g + j * 256 + lane * 4); bv[j] = *(const f32x4*)(b + j * 256 + lane * 4); }
    for (int row0 = obid() * 8 + wid; row0 < MTOK; row0 += 2 * nw) {
        f32x4 v[2][4];
#pragma unroll
        for (int u = 0; u < 2; ++u) { const int row = row0 + u * nw; const float* sp = src + (size_t)(row < MTOK ? row : row0) * DM;
#pragma unroll
            for (int j = 0; j < 4; ++j) v[u][j] = *(const f32x4*)(sp + j * 256 + lane * 4); }
#pragma unroll
        for (int u = 0; u < 2; ++u) {
            const int row = row0 + u * nw; if (row >= MTOK) break;
            float s = 0.f;
#pragma unroll
            for (int j = 0; j < 4; ++j) s += v[u][j][0] + v[u][j][1] + v[u][j][2] + v[u][j][3];
            const float mean = wave_sum(s) * (1.f / DM);
            float q = 0.f;
#pragma unroll
            for (int j = 0; j < 4; ++j) { v[u][j] -= mean; q += v[u][j][0] * v[u][j][0] + v[u][j][1] * v[u][j][1] + v[u][j][2] * v[u][j][2] + v[u][j][3] * v[u][j][3]; }
            const float rstd = rsqrtf(wave_sum(q) * (1.f / DM) + LN_EPS);
#pragma unroll
            for (int j = 0; j < 4; ++j) {
                const f32x4 y = v[u][j] * rstd * gv[j] + bv[j];
                if (dstf) *(f32x4*)(dstf + (size_t)row * DM + j * 256 + lane * 4) = y;
                if (dstb) { u32x2 w; w.x = cvt_pk_bf16(y[0], y[1]); w.y = cvt_pk_bf16(y[2], y[3]); *(u32x2*)(dstb + (size_t)row * DM + j * 256 + lane * 4) = w; }
            }
        }
    }
}

constexpr int TLD = 257;
__device__ __forceinline__ void transpose_tile(const float* __restrict__ W, bf16_t* __restrict__ Wt, int K, int N, int tile, float* tl, bool glu) {
    const int tn = N >> 8; const int k0 = (tile / tn) * 64, n0 = (tile % tn) * 256; const int tid = otid();
    f32x4 v[8];
#pragma unroll
    for (int i = 0; i < 8; ++i) { const int q = tid + i * NTHR, kk = q >> 6, n4 = (q & 63) * 4;
        int ns = n0 + n4;
        if (glu && n0 >= 768) { const int blk = (n0 - 768) >> 8; ns = (n4 < 128) ? 768 + blk * 128 + n4 : 1280 + blk * 128 + (n4 - 128); }
        v[i] = *(const f32x4*)(W + (size_t)(k0 + kk) * N + ns); }
#pragma unroll
    for (int i = 0; i < 8; ++i) { const int q = tid + i * NTHR, kk = q >> 6, n4 = (q & 63) * 4; float* d = tl + kk * TLD + n4; d[0] = v[i][0]; d[1] = v[i][1]; d[2] = v[i][2]; d[3] = v[i][3]; }
    __syncthreads();
#pragma unroll
    for (int i = 0; i < 4; ++i) { const int q = tid + i * NTHR, nn = q >> 3, kc = (q & 7) * 8; float x[8];
#pragma unroll
        for (int j = 0; j < 8; ++j) x[j] = tl[(kc + j) * TLD + nn];
        u32x4 w; w.x = cvt_pk_bf16(x[0], x[1]); w.y = cvt_pk_bf16(x[2], x[3]); w.z = cvt_pk_bf16(x[4], x[5]); w.w = cvt_pk_bf16(x[6], x[7]);
        *(u32x4*)(Wt + (size_t)(n0 + nn) * K + k0 + kc) = w; }
    __syncthreads();
}

__device__ __forceinline__ void phase_prep(const Params& p, char* lds) {
    unsigned char* ws = p.ws; float* tl = (float*)lds;
    constexpr int T0 = 112, T1 = T0 + 64, T2 = T1 + 64, T3 = T2 + 128, T4 = T3 + 64, T5 = T4 + 256, T6 = T5 + 256;
    for (int t = blockIdx.x; t < T6; t += gridDim.x) {
        if (t < T0) transpose_tile(p.in[4], (bf16_t*)(ws + OFF_WIN), DM, INC, t, tl, true);
        else if (t < T1) transpose_tile(p.in[13], (bf16_t*)(ws + OFF_WOUT), DM, DM, t - T0, tl, false);
        else if (t < T2) transpose_tile(p.in[16], (bf16_t*)(ws + OFF_WMQ), DM, DM, t - T1, tl, false);
        else if (t < T3) transpose_tile(p.in[17], (bf16_t*)(ws + OFF_WMKV), DM, 2 * DM, t - T2, tl, false);
        else if (t < T4) transpose_tile(p.in[18], (bf16_t*)(ws + OFF_WMO), DM, DM, t - T3, tl, false);
        else if (t < T5) transpose_tile(p.in[21], (bf16_t*)(ws + OFF_WFF1), DM, DFF, t - T4, tl, false);
        else transpose_tile(p.in[23], (bf16_t*)(ws + OFF_WFF2), DFF, DM, t - T5, tl, false);
    }
    { float* sm = (float*)(ws + OFF_SMALL); const int gt = blockIdx.x * NTHR + threadIdx.x, gs = gridDim.x * NTHR;
#define CPY(idx, off, n) for (int i = gt; i < (n); i += gs) sm[(off) + i] = p.in[idx][i];
      CPY(5, SM_QG, 64) CPY(6, SM_KG, 64) CPY(7, SM_CONVW, 31 * 512) CPY(8, SM_CONVB, 512) CPY(9, SM_CLNG, 512) CPY(10, SM_CLNB, 512)
      CPY(11, SM_AOG, 512) CPY(12, SM_COG, 512) CPY(14, SM_LN1G, 1024) CPY(15, SM_LN1B, 1024) CPY(19, SM_LN2G, 1024) CPY(20, SM_LN2B, 1024)
      CPY(22, SM_BFF1, 4096) CPY(24, SM_BFF2, 1024) CPY(25, SM_LN3G, 1024) CPY(26, SM_LN3B, 1024)
#undef CPY
    }
    ln_rows(p.in[0], (float*)(ws + OFF_A), (bf16_t*)(ws + OFF_B), p.in[2], p.in[3]);
    { const float* mem = p.in[1]; bf16_t* mb = (bf16_t*)(ws + OFF_MEMB);
      for (size_t i = ((size_t)blockIdx.x * NTHR + threadIdx.x) * 8; i < (size_t)MMEM * DM; i += (size_t)gridDim.x * NTHR * 8) {
          const f32x4 a = *(const f32x4*)(mem + i), b = *(const f32x4*)(mem + i + 4);
          u32x4 w; w.x = cvt_pk_bf16(a[0], a[1]); w.y = cvt_pk_bf16(a[2], a[3]); w.z = cvt_pk_bf16(b[0], b[1]); w.w = cvt_pk_bf16(b[2], b[3]);
          *(u32x4*)(mb + i) = w; } }
}

__device__ __forceinline__ void qk_chunk(const u32x4 raw, long g, const float* qg, const float* kg, bf16_t* qR, bf16_t* kR) {
    const int tok = (int)(g / 80), ch = (int)(g % 80), head = ch >> 3, part = ch & 7;
    float x[8]; x[0] = bflo(raw.x); x[1] = bfhi(raw.x); x[2] = bflo(raw.y); x[3] = bfhi(raw.y); x[4] = bflo(raw.z); x[5] = bfhi(raw.z); x[6] = bflo(raw.w); x[7] = bfhi(raw.w);
    float ss = 0.f;
#pragma unroll
    for (int j = 0; j < 8; ++j) ss += x[j] * x[j];
    ss = sum8(ss);
    const float rs = rsqrtf(ss * (1.f / 64.f) + LN_EPS);
    const float* gp = (head < 8 ? qg : kg) + part * 8;
    const f32x4 ga = *(const f32x4*)gp, gb = *(const f32x4*)(gp + 4);
    x[0] *= rs * ga[0]; x[1] *= rs * ga[1]; x[2] *= rs * ga[2]; x[3] *= rs * ga[3];
    x[4] *= rs * gb[0]; x[5] *= rs * gb[1]; x[6] *= rs * gb[2]; x[7] *= rs * gb[3];
    const int s = tok & (SEQ - 1);
    const float pos = (float)((part < 4) ? (s >> 6) : (s & 63));
    float y[8];
#pragma unroll
    for (int jj = 0; jj < 4; ++jj) {
        const int fi = (part & 3) * 4 + jj;
        const float inv = exp2f(-(float)fi * (13.287712379549449f / 16.f));
        const float ang = pos * inv;
        float sn, cs; __sincosf(ang, &sn, &cs);
        y[2 * jj] = x[2 * jj] * cs - x[2 * jj + 1] * sn;
        y[2 * jj + 1] = x[2 * jj] * sn + x[2 * jj + 1] * cs;
    }
    u32x4 w; w.x = cvt_pk_bf16(y[0], y[1]); w.y = cvt_pk_bf16(y[2], y[3]); w.z = cvt_pk_bf16(y[4], y[5]); w.w = cvt_pk_bf16(y[6], y[7]);
    if (head < 8) *(u32x4*)(qR + (size_t)tok * 512 + head * 64 + part * 8) = w;
    else *(u32x4*)(kR + (size_t)tok * 128 + (head - 8) * 64 + part * 8) = w;
}
__device__ __forceinline__ void phase_qk(const Params& p) {
    const bf16_t* proj = (const bf16_t*)(p.ws + OFF_T);
    bf16_t* qR = (bf16_t*)(p.ws + OFF_Q); bf16_t* kR = (bf16_t*)(p.ws + OFF_KR);
    const float* sm = (const float*)(p.ws + OFF_SMALL); const float* qg = sm + SM_QG; const float* kg = sm + SM_KG;
    const long total = (long)MTOK * 80, stride = (long)ogrid() * NTHR;
    for (long g0 = (long)obid() * NTHR + otid(); g0 < total; g0 += 5 * stride) {
        u32x4 raw[5];
#pragma unroll
        for (int k = 0; k < 5; ++k) { const long g = g0 + k * stride; raw[k] = (u32x4){0u, 0u, 0u, 0u};
            if (g < total) { const int tok = (int)(g / 80), ch = (int)(g % 80), head = ch >> 3, part = ch & 7; const int col = (head < 8) ? head * 64 : 512 + (head - 8) * 64;
                raw[k] = *(const u32x4*)(proj + (size_t)tok * 768 + col + part * 8); } }
#pragma unroll
        for (int k = 0; k < 5; ++k) { const long g = g0 + k * stride; if (g < total) qk_chunk(raw[k], g, qg, kg, qR, kR); }
    }
}

constexpr int CT = 32, CROWS = CT + 30;
__device__ __forceinline__ void phase_conv(const Params& p, char* lds) {
    const bf16_t* Ug = (const bf16_t*)(p.ws + OFF_U);
    bf16_t* Y = (bf16_t*)(p.ws + OFF_Y);
    const float* sm = (const float*)(p.ws + OFF_SMALL);
    bf16_t* Ub = (bf16_t*)lds;
    float* Z = (float*)(lds + CROWS * 512 * 2);
    static_assert(CROWS * 512 * 2 + CT * 512 * 4 <= LDS_MAIN, "conv LDS");
    const int tid = otid(), c = tid, lane = tid & 63, wid = tid >> 6;
    float w[31];
#pragma unroll
    for (int j = 0; j < 31; ++j) w[j] = sm[SM_CONVW + j * 512 + c];
    const float cb = sm[SM_CONVB + c];
    const f32x4 lg0 = *(const f32x4*)(sm + SM_CLNG + lane * 8), lg1 = *(const f32x4*)(sm + SM_CLNG + lane * 8 + 4);
    const f32x4 lb0 = *(const f32x4*)(sm + SM_CLNB + lane * 8), lb1 = *(const f32x4*)(sm + SM_CLNB + lane * 8 + 4);
    const f32x4 og0 = *(const f32x4*)(sm + SM_COG + lane * 8), og1 = *(const f32x4*)(sm + SM_COG + lane * 8 + 4);
    for (int tile = obid(); tile < MTOK / CT; tile += ogrid()) {
        const int tok0 = tile * CT, bb = tok0 / SEQ, s0 = tok0 % SEQ;
        { u32x4 sv[8];
#pragma unroll
          for (int i = 0; i < 8; ++i) { const int q = tid + i * NTHR, r = q >> 6, c8 = (q & 63) * 8; const int s = s0 - 15 + r;
              sv[i] = (u32x4){0u, 0u, 0u, 0u};
              if (q < CROWS * 64 && s >= 0 && s < SEQ) sv[i] = *(const u32x4*)(Ug + (size_t)(bb * SEQ + s) * 512 + c8); }
#pragma unroll
          for (int i = 0; i < 8; ++i) { const int q = tid + i * NTHR, r = q >> 6, c8 = (q & 63) * 8;
              if (q < CROWS * 64) *(u32x4*)(Ub + r * 512 + c8) = sv[i]; } }
        __syncthreads();
        {
            float acc[CT];
#pragma unroll
            for (int t = 0; t < CT; ++t) acc[t] = cb;
#pragma unroll
            for (int r = 0; r < CROWS; ++r) {
                const float uv = bf2f(Ub[r * 512 + c]);
#pragma unroll
                for (int t = 0; t < CT; ++t) { const int j = r - t; if (j >= 0 && j <= 30) acc[t] = fmaf(uv, w[j], acc[t]); }
            }
#pragma unroll
            for (int t = 0; t < CT; ++t) Z[t * 512 + c] = acc[t];
        }
        __syncthreads();
#pragma unroll
        for (int k = 0; k < 4; ++k) {
            const int t = wid * 4 + k;
            f32x4 x0 = *(const f32x4*)(Z + t * 512 + lane * 8), x1 = *(const f32x4*)(Z + t * 512 + lane * 8 + 4);
            float s1 = (x0[0] + x0[1]) + (x0[2] + x0[3]) + (x1[0] + x1[1]) + (x1[2] + x1[3]);
            float s2 = x0[0] * x0[0] + x0[1] * x0[1] + x0[2] * x0[2] + x0[3] * x0[3] + x1[0] * x1[0] + x1[1] * x1[1] + x1[2] * x1[2] + x1[3] * x1[3];
            s1 = wave_sum(s1); s2 = wave_sum(s2);
            const float mean = s1 * (1.f / 512.f); const float var = fmaxf(s2 * (1.f / 512.f) - mean * mean, 0.f); const float rstd = rsqrtf(var + LN_EPS);
            f32x4 y0 = (x0 - mean) * rstd * lg0 + lb0, y1 = (x1 - mean) * rstd * lg1 + lb1;
            float gs = 0.f;
#pragma unroll
            for (int j = 0; j < 4; ++j) { y0[j] *= sigmoidf_(y0[j]); y1[j] *= sigmoidf_(y1[j]); gs += y0[j] * y0[j] + y1[j] * y1[j]; }
            gs = sum8(gs);
            const float rs = rsqrtf(gs * (1.f / 64.f) + LN_EPS);
            y0 = y0 * rs * og0; y1 = y1 * rs * og1;
            u32x4 wv; wv.x = cvt_pk_bf16(y0[0], y0[1]); wv.y = cvt_pk_bf16(y0[2], y0[3]); wv.z = cvt_pk_bf16(y1[0], y1[1]); wv.w = cvt_pk_bf16(y1[2], y1[3]);
            *(u32x4*)(Y + (size_t)(tok0 + t) * DM + 512 + lane * 8) = wv;
        }
    }
    __syncthreads();
}

__device__ __forceinline__ void phase_attn(const Params& p, char* lds) {
    const bf16_t* proj = (const bf16_t*)(p.ws + OFF_T);
    const bf16_t* qR = (const bf16_t*)(p.ws + OFF_Q); const bf16_t* kR = (const bf16_t*)(p.ws + OFF_KR);
    bf16_t* Y = (bf16_t*)(p.ws + OFF_Y);
    for (int item = obid(); item < BATCH * 8 * (SEQ / 256); item += ogrid()) {
        const int qb = item & 7, h = (item >> 3) & 7, b = item >> 6, kvh = h >> 2;
        const size_t tok0 = (size_t)b * SEQ;
        att::attn_body(qR + (tok0 + qb * 256) * 512 + h * 64, kR + tok0 * 128 + kvh * 64, proj + tok0 * 768 + 640 + kvh * 64,
                       Y + (tok0 + qb * 256) * DM + h * 64, (const float*)(p.ws + OFF_SMALL) + SM_AOG + h * 64, SEQ, lds);
    }
}

__device__ __forceinline__ void phase_softmax(const Params& p) {
    const float* Sc = (const float*)(p.ws + OFF_T); bf16_t* P = (bf16_t*)(p.ws + OFF_Y);
    const int tid = otid(), lane = tid & 63, wid = tid >> 6; const int nw = ogrid() * 8;
    for (int row = obid() * 8 + wid; row < MTOK; row += nw) {
#pragma unroll
        for (int h = 0; h < 4; ++h) {
            const f32x4 v = *(const f32x4*)(Sc + (size_t)row * DM + h * 256 + lane * 4);
            const float mx = wave_max(fmaxf(fmaxf(v[0], v[1]), fmaxf(v[2], v[3])));
            const float e0 = __expf(v[0] - mx), e1 = __expf(v[1] - mx), e2 = __expf(v[2] - mx), e3 = __expf(v[3] - mx);
            const float inv = 1.f / wave_sum(e0 + e1 + e2 + e3);
            u32x2 w; w.x = cvt_pk_bf16(e0 * inv, e1 * inv); w.y = cvt_pk_bf16(e2 * inv, e3 * inv);
            *(u32x2*)(P + (size_t)row * DM + h * 256 + lane * 4) = w;
        }
    }
}

__device__ __forceinline__ GemmDesc plain_gemm(const bf16_t* A, int lda, const bf16_t* Bt, int ldb, int M, int N, int K, int shift,
                                               int kind, void* out, int ldc, const float* bias, float scale, int act, float alpha) {
    GemmDesc d; d.A = A; d.Bt = Bt; d.lda = lda; d.ldb = ldb; d.K = K; d.nM = M / BM; d.nN = N / BM; d.nZ = 1; d.zdiv = 1;
    d.sA0 = d.sA1 = d.sB0 = d.sB1 = 0; d.rz0 = 0; d.cz1 = 0; d.shift = shift; d.kind = kind; d.out = out; d.out2 = nullptr; d.ldc = ldc; d.bias = bias; d.scale = scale; d.act = act; d.alpha = alpha;
    return d;
}

enum { PH_PREP = 0, PH_G1, PH_QKCONV, PH_ATTN, PH_G2, PH_LN1, PH_G3, PH_G4, PH_SOFTMAX, PH_G5, PH_G6, PH_LN2, PH_G7, PH_G8, PH_LN3, PH_COUNT };

__device__ __forceinline__ int gemm_count(int ph) {
    switch (ph) { case PH_G1: return 3; case PH_G2: case PH_G3: case PH_G4: case PH_G5: case PH_G6: case PH_G7: case PH_G8: return 1; default: return 0; }
}
__device__ __forceinline__ GemmDesc make_desc(const Params& p, int ph, int gi) {
    unsigned char* ws = p.ws;
    const bf16_t* Bh = (const bf16_t*)(ws + OFF_B);
    switch (ph) {
    case PH_G1:
        if (gi == 0) { GemmDesc d = plain_gemm(Bh, DM, (const bf16_t*)(ws + OFF_WIN), DM, MTOK, INC, DM, 0, 2, ws + OFF_T, 768, nullptr, 1.f, 0, 0.f); d.out2 = ws + OFF_U; return d; }
        if (gi == 1) return plain_gemm((const bf16_t*)(ws + OFF_MEMB), DM, (const bf16_t*)(ws + OFF_WMKV), DM, MMEM, DM, DM, 192, 0, ws + OFF_MEMK, DM, nullptr, 1.f, 0, 0.f);
        return plain_gemm((const bf16_t*)(ws + OFF_WMKV) + (size_t)DM * DM, DM, (const bf16_t*)(ws + OFF_MEMB), DM, DM, MMEM, DM, 224, 0, ws + OFF_MEMVT, MMEM, nullptr, 1.f, 0, 0.f);
    case PH_G2:
        return plain_gemm((const bf16_t*)(ws + OFF_Y), DM, (const bf16_t*)(ws + OFF_WOUT), DM, MTOK, DM, DM, 0, 1, ws + OFF_A, DM, nullptr, 1.f, 0, ALPHA);
    case PH_G3:
        return plain_gemm(Bh, DM, (const bf16_t*)(ws + OFF_WMQ), DM, MTOK, DM, DM, 0, 0, ws + OFF_Y, DM, nullptr, 1.f, 0, 0.f);
    case PH_G4: {
        GemmDesc d = plain_gemm((const bf16_t*)(ws + OFF_Y), DM, (const bf16_t*)(ws + OFF_MEMK), DM, SEQ, NMEM, 256, 0, 1, ws + OFF_T, DM, nullptr, 0.0625f, 0, 0.f);
        d.nZ = BATCH * 4; d.zdiv = 4; d.sA0 = (long)SEQ * DM; d.sA1 = 256; d.sB0 = (long)NMEM * DM; d.sB1 = 256; d.rz0 = SEQ; d.cz1 = 256; return d; }
    case PH_G5: {
        GemmDesc d = plain_gemm((const bf16_t*)(ws + OFF_Y), DM, (const bf16_t*)(ws + OFF_MEMVT), MMEM, SEQ, 256, 256, 0, 0, ws + OFF_T, DM, nullptr, 1.f, 0, 0.f);
        d.nZ = BATCH * 4; d.zdiv = 4; d.sA0 = (long)SEQ * DM; d.sA1 = 256; d.sB0 = NMEM; d.sB1 = (long)256 * MMEM; d.rz0 = SEQ; d.cz1 = 256; return d; }
    case PH_G6:
        return plain_gemm((const bf16_t*)(ws + OFF_T), DM, (const bf16_t*)(ws + OFF_WMO), DM, MTOK, DM, DM, 0, 1, ws + OFF_A, DM, nullptr, 1.f, 0, ALPHA);
    case PH_G7:
        return plain_gemm(Bh, DM, (const bf16_t*)(ws + OFF_WFF1), DM, MTOK, DFF, DM, 0, 0, ws + OFF_A1, DFF, (const float*)(ws + OFF_SMALL) + SM_BFF1, 1.f, 1, 0.f);
    default:
        return plain_gemm((const bf16_t*)(ws + OFF_A1), DFF, (const bf16_t*)(ws + OFF_WFF2), DFF, MTOK, DM, DFF, 0, 1, ws + OFF_A, DM, (const float*)(ws + OFF_SMALL) + SM_BFF2, 1.f, 0, ALPHA);
    }
}

#ifdef PROBE_TS
#define TS_STAMP(k) do { if (blockIdx.x == 0 && threadIdx.x == 0) ((volatile unsigned long long*)(ws + OFF_TS))[k] = __builtin_amdgcn_s_memrealtime(); } while (0)
#else
#define TS_STAMP(k) do { } while (0)
#endif
__global__ void __launch_bounds__(NTHR) mega(Params p) {
    extern __shared__ __attribute__((aligned(16))) unsigned char lds_raw[];
    cg::grid_group grid = cg::this_grid();
    unsigned char* ws = p.ws;
    volatile LAS unsigned* bst = (volatile LAS unsigned*)((LAS unsigned char*)lds_raw + LDS_MAIN);
    if (threadIdx.x < 4) bst[threadIdx.x] = 0u;
    __syncthreads();
    const XcdBarrier xb = xcd_barrier_post((unsigned*)(ws + OFF_BAR), bst);
    if (p.ph_lo < 0) grid.sync();
    TS_STAMP(0);
    int ph0 = p.ph_lo;
    if (ph0 == PH_PREP) {
        phase_prep(p, (char*)lds_raw);
#ifdef REPEAT_MASK
        if (REPEAT_MASK & 1) phase_prep(p, (char*)lds_raw);
#endif
        if (1 < p.ph_hi) xcd_barrier(xb);
        TS_STAMP(1);
        ph0 = 1;
    }
#pragma nounroll
    for (int ph = ph0; ph < p.ph_hi; ++ph) {
#ifdef REPEAT_MASK
#pragma nounroll
      for (int rep = 0; rep < (((REPEAT_MASK >> ph) & 1) ? 2 : 1); ++rep) {
#else
      {
#endif
        const int ng = gemm_count(ph);
        if (ng > 0) {
#pragma nounroll
            for (int gi = 0; gi < ng; ++gi) { const GemmDesc d = make_desc(p, ph, gi); gemm_phase((LAS unsigned char*)lds_raw, d); }
        } else if (ph == PH_QKCONV) {
            phase_qk(p);
            phase_conv(p, (char*)lds_raw);
        } else if (ph == PH_ATTN) {
            phase_attn(p, (char*)lds_raw);
        } else if (ph == PH_LN1) {
            ln_rows((const float*)(ws + OFF_A), (float*)(ws + OFF_A), (bf16_t*)(ws + OFF_B), (const float*)(ws + OFF_SMALL) + SM_LN1G, (const float*)(ws + OFF_SMALL) + SM_LN1B);
        } else if (ph == PH_SOFTMAX) {
            phase_softmax(p);
        } else if (ph == PH_LN2) {
            ln_rows((const float*)(ws + OFF_A), (float*)(ws + OFF_A), (bf16_t*)(ws + OFF_B), (const float*)(ws + OFF_SMALL) + SM_LN2G, (const float*)(ws + OFF_SMALL) + SM_LN2B);
        } else if (ph == PH_LN3) {
            ln_rows((const float*)(ws + OFF_A), p.out, nullptr, (const float*)(ws + OFF_SMALL) + SM_LN3G, (const float*)(ws + OFF_SMALL) + SM_LN3B);
        }
      }
        if (ph + 1 < p.ph_hi) xcd_barrier(xb);
        TS_STAMP(ph + 1);
    }
#ifdef PROBE_TS
    xcd_barrier(xb);
    if (blockIdx.x == 0) {
        const volatile unsigned long long* ts = (const volatile unsigned long long*)(ws + OFF_TS);
        const float da = (float)(ts[PROBE_A_HI + 1] - ts[PROBE_A_LO]) * 0.01f, db = (float)(ts[PROBE_B_HI + 1] - ts[PROBE_B_LO]) * 0.01f;
        for (int i = threadIdx.x; i < MTOK * DM; i += NTHR) p.out[i] = (i == 0) ? da * 1000.f : db;
    }
#endif
}

extern "C" void kernel_launch(void* const* d_in, const int* in_sizes, int n_in, void* d_out, int out_size, void* d_ws, size_t ws_size, hipStream_t stream) {
    static int grid = 0;
    if (grid == 0) {
        if (n_in != 27 || ws_size < WS_END) { fprintf(stderr, "kernel_launch: unexpected n_in %d / ws_size %zu (need %zu)\n", n_in, ws_size, (size_t)WS_END); grid = -1; return; }
        int dev = 0, cus = 0, per_cu = 0;
        (void)hipGetDevice(&dev);
        (void)hipDeviceGetAttribute(&cus, hipDeviceAttributeMultiprocessorCount, dev);
        if (hipFuncSetAttribute((const void*)mega, hipFuncAttributeMaxDynamicSharedMemorySize, LDS_BYTES) != hipSuccess) { fprintf(stderr, "kernel_launch: hipFuncSetAttribute failed\n"); grid = -1; return; }
        if (hipOccupancyMaxActiveBlocksPerMultiprocessor(&per_cu, (const void*)mega, NTHR, LDS_BYTES) != hipSuccess || per_cu < 1) { fprintf(stderr, "kernel_launch: occupancy query says %d\n", per_cu); per_cu = 1; }
        (void)hipGetLastError();
        grid = cus * per_cu;
        fprintf(stderr, "kernel_launch: grid %d (cus %d x %d)\n", grid, cus, per_cu);
    }
    if (grid < 0) return;
    Params p{};
    for (int i = 0; i < 27; ++i) p.in[i] = (const float*)d_in[i];
    p.out = (float*)d_out; p.ws = (unsigned char*)d_ws; p.ph_lo = 0; p.ph_hi = PH_COUNT;
    if (hipMemsetAsync((char*)d_ws + OFF_BAR, 0, BAR_BYTES, stream) != hipSuccess) { fprintf(stderr, "kernel_launch: memset failed\n"); return; }
    void* args[] = {&p};
    hipError_t e = hipLaunchCooperativeKernel((const void*)mega, dim3(grid), dim3(NTHR), args, LDS_BYTES, stream);
    if (e != hipSuccess) fprintf(stderr, "kernel_launch: cooperative launch failed: %s (grid %d)\n", hipGetErrorString(e), grid);
}
```

```cpp
#include <hip/hip_runtime.h>
#include <hip/hip_cooperative_groups.h>
#include <cstdio>
#include <cstdint>
namespace cg = cooperative_groups;

#define LAS __attribute__((address_space(3)))
typedef unsigned short bf16_t;
typedef short bf16x8 __attribute__((ext_vector_type(8)));
typedef short s16x4 __attribute__((ext_vector_type(4)));
typedef float f32x4 __attribute__((ext_vector_type(4)));
typedef float f32x16 __attribute__((ext_vector_type(16)));
typedef unsigned u32x4 __attribute__((ext_vector_type(4)));
typedef unsigned u32x2 __attribute__((ext_vector_type(2)));

constexpr int NTHR = 512;
constexpr int BATCH = 8, SEQ = 2048, DM = 1024, MTOK = BATCH * SEQ, NMEM = 256, MMEM = BATCH * NMEM, DFF = 4096, INC = 1792;
constexpr float LN_EPS = 1e-5f;
constexpr float ALPHA = 1.189207115002721f;
constexpr int LDS_MAIN = 131072;
constexpr int LDS_BYTES = LDS_MAIN + 16;

constexpr size_t MiB = 1024 * 1024;
constexpr size_t OFF_WIN = 0;
constexpr size_t OFF_WOUT = OFF_WIN + (size_t)INC * DM * 2;
constexpr size_t OFF_WMQ = OFF_WOUT + (size_t)DM * DM * 2;
constexpr size_t OFF_WMKV = OFF_WMQ + (size_t)DM * DM * 2;
constexpr size_t OFF_WMO = OFF_WMKV + (size_t)2 * DM * DM * 2;
constexpr size_t OFF_WFF1 = OFF_WMO + (size_t)DM * DM * 2;
constexpr size_t OFF_WFF2 = OFF_WFF1 + (size_t)DFF * DM * 2;
constexpr size_t OFF_A = OFF_WFF2 + (size_t)DFF * DM * 2;
constexpr size_t OFF_B = OFF_A + 64 * MiB;
constexpr size_t OFF_REST = OFF_B + 32 * MiB;
constexpr size_t OFF_MEMB = OFF_REST;
constexpr size_t OFF_MEMK = OFF_REST + 4 * MiB;
constexpr size_t OFF_MEMVT = OFF_REST + 8 * MiB;
constexpr size_t OFF_T = OFF_REST + 12 * MiB;
constexpr size_t OFF_U = OFF_T + 24 * MiB;
constexpr size_t OFF_Y = OFF_T + 64 * MiB;
constexpr size_t OFF_Q = OFF_Y + 32 * MiB;
constexpr size_t OFF_KR = OFF_Q + 16 * MiB;
constexpr size_t OFF_A1 = OFF_REST;
constexpr size_t OFF_SMALL = OFF_REST + 128 * MiB;
constexpr size_t OFF_BAR = OFF_SMALL + 128 * 1024;
constexpr size_t BAR_BYTES = 16384;
constexpr size_t OFF_TS = OFF_BAR + BAR_BYTES;
constexpr size_t WS_END = OFF_TS + 1024;
constexpr int SM_QG = 0, SM_KG = 64, SM_CONVW = 128, SM_CONVB = SM_CONVW + 31 * 512, SM_CLNG = SM_CONVB + 512, SM_CLNB = SM_CLNG + 512,
              SM_AOG = SM_CLNB + 512, SM_COG = SM_AOG + 512, SM_LN1G = SM_COG + 512, SM_LN1B = SM_LN1G + 1024, SM_LN2G = SM_LN1B + 1024,
              SM_LN2B = SM_LN2G + 1024, SM_BFF1 = SM_LN2B + 1024, SM_BFF2 = SM_BFF1 + 4096, SM_LN3G = SM_BFF2 + 1024, SM_LN3B = SM_LN3G + 1024,
              SM_END = SM_LN3B + 1024;
static_assert(SM_END * 4 <= 128 * 1024, "small block");

struct Params {
    const float* in[27];
    float* out;
    unsigned char* ws;
    int ph_lo, ph_hi;
};

__device__ __forceinline__ unsigned cvt_pk_bf16(float lo, float hi) { unsigned r; asm volatile("v_cvt_pk_bf16_f32 %0, %1, %2" : "=v"(r) : "v"(lo), "v"(hi)); return r; }
__device__ __forceinline__ float bf2f(unsigned short b) { return __uint_as_float(((unsigned)b) << 16); }
__device__ __forceinline__ float bflo(unsigned w) { return __uint_as_float(w << 16); }
__device__ __forceinline__ float bfhi(unsigned w) { return __uint_as_float(w & 0xffff0000u); }
template <int CTRL> __device__ __forceinline__ float dpp_f(float v) { return __int_as_float(__builtin_amdgcn_update_dpp(0, __float_as_int(v), CTRL, 0xF, 0xF, true)); }
__device__ __forceinline__ float rdlane(float v, int l) { return __int_as_float(__builtin_amdgcn_readlane(__float_as_int(v), l)); }
__device__ __forceinline__ float sum8(float v) { v += dpp_f<0xB1>(v); v += dpp_f<0x4E>(v); v += dpp_f<0x141>(v); return v; }
__device__ __forceinline__ float sum16(float v) { v = sum8(v); v += dpp_f<0x140>(v); return v; }
__device__ __forceinline__ float wave_sum(float v) { v = sum16(v); return (rdlane(v, 0) + rdlane(v, 16)) + (rdlane(v, 32) + rdlane(v, 48)); }
__device__ __forceinline__ float wave_max(float v) {
    v = fmaxf(v, dpp_f<0xB1>(v)); v = fmaxf(v, dpp_f<0x4E>(v)); v = fmaxf(v, dpp_f<0x141>(v)); v = fmaxf(v, dpp_f<0x140>(v));
    return fmaxf(fmaxf(rdlane(v, 0), rdlane(v, 16)), fmaxf(rdlane(v, 32), rdlane(v, 48)));
}
__device__ __forceinline__ int otid() { int t = threadIdx.x; asm volatile("" : "+v"(t)); return t; }
__device__ __forceinline__ int obid() { int t = blockIdx.x; asm volatile("" : "+s"(t)); return t; }
__device__ __forceinline__ int ogrid() { int t = gridDim.x; asm volatile("" : "+s"(t)); return t; }
__device__ __forceinline__ float sigmoidf_(float x) { return __builtin_amdgcn_rcpf(1.f + __expf(-x)); }


#define XB_TMO      128
#define XB_XCNT(j)  (256  + 64 * (j))
#define XB_XSUB(j)  (1280 + 64 * (j))
#define XB_XGEN(j)  (2304 + 64 * (j))
#define XB_TOP      3328
#define XB_TOPGEN   3392
#define XCD_BAR_WORDS 3456
#define XB_SPIN_CAP (1u << 22)
static_assert(XCD_BAR_WORDS * 4 <= BAR_BYTES, "barrier words");
__device__ __forceinline__ unsigned xb_ld(unsigned* p)              { return __hip_atomic_load(p, __ATOMIC_RELAXED, __HIP_MEMORY_SCOPE_AGENT); }
__device__ __forceinline__ unsigned xb_add(unsigned* p, unsigned v) { return __hip_atomic_fetch_add(p, v, __ATOMIC_RELAXED, __HIP_MEMORY_SCOPE_AGENT); }
__device__ __forceinline__ unsigned xb_xcc_id() { return (unsigned)__builtin_amdgcn_s_getreg((3 << 11) | 20) & 0xFu; }
#define XB_SPIN(cond, bar) do { unsigned _sp = 0; while (cond) { __builtin_amdgcn_s_sleep(1); \
    if ((++_sp & 255u) == 0u) { if (xb_ld(&(bar)[XB_TMO])) break; if (_sp > XB_SPIN_CAP) { atomicAdd(&(bar)[XB_TMO], 1u); break; } } } } while (0)
struct XcdBarrier { unsigned* bar; unsigned x; volatile LAS unsigned* st; };
__device__ __forceinline__ XcdBarrier xcd_barrier_post(unsigned* bar, volatile LAS unsigned* st) {
    XcdBarrier b; b.bar = bar; b.x = xb_xcc_id(); b.st = st;
    if (threadIdx.x == 0) (void)xb_add(&bar[XB_XCNT(b.x)], 1u);
    return b;
}
__device__ __forceinline__ void xcd_barrier_complete(unsigned* bar, unsigned x, unsigned& nloc, unsigned& nx) {
    const unsigned G = gridDim.x * gridDim.y * gridDim.z;
    unsigned sum, cnt, mine, sp = 0u;
    for (;;) {
        sum = 0u; cnt = 0u; mine = 0u;
#pragma unroll
        for (unsigned j = 0; j < 16; ++j) { const unsigned c = xb_ld(&bar[XB_XCNT(j)]); sum += c; cnt += (c > 0u) ? 1u : 0u; mine = (j == x) ? c : mine; }
        if (sum == G) break;
        __builtin_amdgcn_s_sleep(1);
        if ((++sp & 255u) == 0u) { if (xb_ld(&bar[XB_TMO])) break; if (sp > XB_SPIN_CAP) { atomicAdd(&bar[XB_TMO], 1u); break; } }
    }
    nloc = mine > 0u ? mine : 1u; nx = cnt > 0u ? cnt : 1u;
}
__device__ __forceinline__ void xcd_barrier(const XcdBarrier& b) {
    asm volatile("s_waitcnt vmcnt(0)" ::: "memory");
    __syncthreads();
    if (threadIdx.x == 0) {
        unsigned* bar = b.bar;
        __builtin_amdgcn_s_waitcnt(0);
        unsigned nloc = b.st[0], nx = b.st[1];
        if (nloc == 0u) { xcd_barrier_complete(bar, b.x, nloc, nx); b.st[0] = nloc; b.st[1] = nx; }
        const unsigned old = xb_add(&bar[XB_XSUB(b.x)], 1u);
        const unsigned gen = old / nloc;
        if (old + 1u == (gen + 1u) * nloc) {
            __builtin_amdgcn_fence(__ATOMIC_RELEASE, "agent");
            asm volatile("s_waitcnt vmcnt(0)" ::: "memory");
            const unsigned og = xb_add(&bar[XB_TOP], 1u);
            const unsigned tg = og / nx;
            if (og + 1u == (tg + 1u) * nx) xb_add(&bar[XB_TOPGEN], 1u);
            else XB_SPIN(xb_ld(&bar[XB_TOPGEN]) == tg, bar);
            __builtin_amdgcn_fence(__ATOMIC_ACQUIRE, "agent");
            xb_add(&bar[XB_XGEN(b.x)], 1u);
            asm volatile("s_waitcnt vmcnt(0)" ::: "memory");
        } else {
            XB_SPIN(xb_ld(&bar[XB_XGEN(b.x)]) == gen, bar);
            __builtin_amdgcn_fence(__ATOMIC_ACQUIRE, "agent");
            asm volatile("s_waitcnt vmcnt(0)" ::: "memory");
        }
    }
    __syncthreads();
}

constexpr int BM = 256, BK = 64, HALF = 128, HTB = HALF * BK * 2, NXCD = 8, WGM = 8;

__device__ __forceinline__ int lds_byte(int r, int c) { const int st = (r >> 4) * 2 + (c >> 5), rr = r & 15, cc = c & 31, ob = rr * 64 + cc * 2; return st * 1024 + (ob ^ (((ob >> 9) & 1) << 5)); }
__device__ __forceinline__ void stage_rc(int b, int& R, int& C) { const int st = b / 1024, sb = b % 1024, swz = sb ^ (((sb >> 9) & 1) << 5); R = (st >> 1) * 16 + swz / 64; C = (st & 1) * 32 + (swz % 64) / 2; }
__device__ __forceinline__ int perm32(int rho) { const int n = rho >> 4, i = rho & 15; return 8 * (i >> 2) + 4 * n + (i & 3); }

struct GemmDesc {
    const bf16_t* A; const bf16_t* Bt; int lda, ldb, K;
    int nM, nN, nZ, zdiv;
    long sA0, sA1, sB0, sB1;
    int rz0, cz1;
    int shift;
    int kind;
    void* out; void* out2; int ldc; const float* bias; float scale; int act; float alpha;
};
struct Unit { const char* a; const char* b; int row0, col0; };

__device__ __forceinline__ bool next_unit(const GemmDesc& d, int i, int G, int c, Unit& u) {
    const int per = d.nM * d.nN; const long L = (long)i * G + c;
    if (L >= (long)per * d.nZ) return false;
    const int z = (int)(L / per); int w = (int)(L % per); int pm, pn;
    if (d.nZ == 1) {
        const int nwg = per; const int q = nwg / NXCD, r = nwg % NXCD, xcd = w % NXCD, off = w / NXCD;
        w = (xcd < r ? xcd * (q + 1) : r * (q + 1) + (xcd - r) * q) + off;
        const int nig = WGM * d.nN, gid = w / nig, fm = gid * WGM, gsz = (d.nM - fm) < WGM ? (d.nM - fm) : WGM;
        pm = fm + ((w % nig) % gsz); pn = (w % nig) / gsz;
    } else { pm = w % d.nM; pn = w / d.nM; }
    const int z0 = z / d.zdiv, z1 = z % d.zdiv;
    u.a = (const char*)(d.A + (long)z0 * d.sA0 + (long)z1 * d.sA1 + (long)pm * BM * d.lda);
    u.b = (const char*)(d.Bt + (long)z0 * d.sB0 + (long)z1 * d.sB1 + (long)pn * BM * d.ldb);
    u.row0 = z0 * d.rz0 + pm * BM; u.col0 = z1 * d.cz1 + pn * BM;
    return true;
}

__device__ __forceinline__ void gemm_epilogue(const f32x4 (&acc)[2][2][4][2], const GemmDesc& d, const Unit& u, int wr, int wc, int fr, int fq) {
    const int row0 = u.row0 + wr * 64 + fr, col0 = u.col0 + wc * 32 + 8 * fq;
    f32x4 bv[2][2];
#pragma unroll
    for (int bj = 0; bj < 2; ++bj)
#pragma unroll
        for (int n = 0; n < 2; ++n) bv[bj][n] = d.bias ? *(const f32x4*)(d.bias + col0 + bj * HALF + 4 * n) : (f32x4){0.f, 0.f, 0.f, 0.f};
    const float sc = d.scale;
    if (d.kind == 2 && u.col0 >= 768) {
        bf16_t* O = (bf16_t*)d.out2; const int ucol = ((u.col0 - 768) >> 1) + wc * 32 + 8 * fq;
#pragma unroll
        for (int ai = 0; ai < 2; ++ai)
#pragma unroll
            for (int m = 0; m < 4; ++m) {
                f32x4 v0 = acc[ai][0][m][0], v1 = acc[ai][0][m][1]; const f32x4 g0 = acc[ai][1][m][0], g1 = acc[ai][1][m][1];
#pragma unroll
                for (int j = 0; j < 4; ++j) { v0[j] *= sigmoidf_(g0[j]); v1[j] *= sigmoidf_(g1[j]); }
                u32x4 w; w.x = cvt_pk_bf16(v0[0], v0[1]); w.y = cvt_pk_bf16(v0[2], v0[3]); w.z = cvt_pk_bf16(v1[0], v1[1]); w.w = cvt_pk_bf16(v1[2], v1[3]);
                *(u32x4*)(O + (size_t)(row0 + ai * HALF + m * 16) * 512 + ucol) = w;
            }
        return;
    }
    if (d.kind != 1) {
        bf16_t* O = (bf16_t*)d.out;
#pragma unroll
        for (int ai = 0; ai < 2; ++ai)
#pragma unroll
            for (int m = 0; m < 4; ++m) {
                bf16_t* rowp = O + (size_t)(row0 + ai * HALF + m * 16) * d.ldc + col0;
#pragma unroll
                for (int bj = 0; bj < 2; ++bj) {
                    f32x4 v0 = acc[ai][bj][m][0] * sc + bv[bj][0], v1 = acc[ai][bj][m][1] * sc + bv[bj][1];
                    if (d.act == 1) {
#pragma unroll
                        for (int j = 0; j < 4; ++j) { float a = fmaxf(v0[j], 0.f), b = fmaxf(v1[j], 0.f); v0[j] = a * a; v1[j] = b * b; }
                    }
                    u32x4 w; w.x = cvt_pk_bf16(v0[0], v0[1]); w.y = cvt_pk_bf16(v0[2], v0[3]); w.z = cvt_pk_bf16(v1[0], v1[1]); w.w = cvt_pk_bf16(v1[2], v1[3]);
                    *(u32x4*)(rowp + bj * HALF) = w;
                }
            }
    } else {
        float* C = (float*)d.out; const float al = d.alpha;
#pragma unroll
        for (int ai = 0; ai < 2; ++ai)
#pragma unroll
            for (int m = 0; m < 4; ++m) {
                float* rowp = C + (size_t)(row0 + ai * HALF + m * 16) * d.ldc + col0;
#pragma unroll
                for (int bj = 0; bj < 2; ++bj) {
                    f32x4 v0 = acc[ai][bj][m][0] * sc + bv[bj][0], v1 = acc[ai][bj][m][1] * sc + bv[bj][1];
                    if (al != 0.f) { const f32x4 o0 = *(const f32x4*)(rowp + bj * HALF), o1 = *(const f32x4*)(rowp + bj * HALF + 4); v0 += o0 * al; v1 += o1 * al; }
                    *(f32x4*)(rowp + bj * HALF) = v0; *(f32x4*)(rowp + bj * HALF + 4) = v1;
                }
            }
    }
}

__device__ __forceinline__ void gemm_phase(LAS unsigned char* lds, const GemmDesc& d) {
    const int tid = otid(), wid = __builtin_amdgcn_readfirstlane(tid >> 6), lane = tid & 63, wr = wid >> 2, wc = wid & 3, fr = lane & 15, fq = lane >> 4;
    const int G = ogrid(); int cblk = obid() - d.shift; if (cblk < 0) cblk += G;
    const int K = d.K, nt = K / BK;
    unsigned voffA[2], voffB[2];
#pragma unroll
    for (int i = 0; i < 2; ++i) { int R, C; stage_rc(tid * 16 + i * 8192, R, C); const int Rb = (R & ~31) + perm32(R & 31);
        voffA[i] = (unsigned)(R * d.lda + C) * 2u; voffB[i] = (unsigned)(Rb * d.ldb + C) * 2u; }
    const size_t kstep = (size_t)(BK * 2);
    const size_t hstepA = (size_t)HALF * d.lda * 2, hstepB = (size_t)HALF * d.ldb * 2;
    const unsigned ldsw = (unsigned)wid * 1024u;
    const int aoff = lds_byte(wr * 64 + fr, fq * 8), boff = lds_byte(wc * 32 + fr, fq * 8);
#define PG8_SA(b, h) (((b) * 2 + (h)) * HTB)
#define PG8_SB(b, h) ((4 + (b) * 2 + (h)) * HTB)
#define PG8_STAGE(bufoff, gbase, voff) do { _Pragma("unroll") for (int _i = 0; _i < 2; ++_i) \
        __builtin_amdgcn_global_load_lds((const unsigned*)((const char*)(gbase) + (voff)[_i]), (LAS unsigned*)(lds + (bufoff) + ldsw + _i * 8192), 16, 0, 0); } while (0)
#define PG8_LDA(dst, b, h) do { _Pragma("unroll") for (int m = 0; m < 4; ++m) _Pragma("unroll") for (int k = 0; k < 2; ++k) dst[m][k] = *(const LAS bf16x8*)(lds + PG8_SA(b, h) + aoff + m * 2048 + k * 1024); } while (0)
#define PG8_LDB(dst, b, h) do { _Pragma("unroll") for (int n = 0; n < 2; ++n) _Pragma("unroll") for (int k = 0; k < 2; ++k) dst[n][k] = *(const LAS bf16x8*)(lds + PG8_SB(b, h) + boff + n * 2048 + k * 1024); } while (0)
#define PG8_MMA(ai, bj, At, Bt) do { __builtin_amdgcn_s_setprio(1); _Pragma("unroll") for (int m = 0; m < 4; ++m) _Pragma("unroll") for (int n = 0; n < 2; ++n) _Pragma("unroll") for (int k = 0; k < 2; ++k) \
        acc[ai][bj][m][n] = __builtin_amdgcn_mfma_f32_16x16x32_bf16(Bt[n][k], At[m][k], acc[ai][bj][m][n], 0, 0, 0); __builtin_amdgcn_s_setprio(0); } while (0)
#define PG8_WAIT_V(n) asm volatile("s_waitcnt vmcnt(" #n ")" ::: "memory")
#define PG8_WAIT_L(n) asm volatile("s_waitcnt lgkmcnt(" #n ")" ::: "memory")
#define PG8_BAR __builtin_amdgcn_s_barrier()
#define PG8_SCHED __builtin_amdgcn_sched_barrier(0)
    Unit cur, nxt; int ui = 0;
    if (!next_unit(d, 0, G, cblk, cur)) return;
    f32x4 acc[2][2][4][2];
#pragma unroll
    for (int a = 0; a < 2; ++a)
#pragma unroll
        for (int b = 0; b < 2; ++b)
#pragma unroll
            for (int m = 0; m < 4; ++m)
#pragma unroll
                for (int n = 0; n < 2; ++n) acc[a][b][m][n] = (f32x4){0.f, 0.f, 0.f, 0.f};
    bf16x8 At[4][2], B0[2][2], B1[2][2];
    const char* cA = cur.a; const char* cB = cur.b;
    PG8_STAGE(PG8_SB(0, 0), cB, voffB); PG8_STAGE(PG8_SA(0, 0), cA, voffA); PG8_STAGE(PG8_SB(0, 1), cB + hstepB, voffB); PG8_STAGE(PG8_SA(0, 1), cA + hstepA, voffA);
    if (wr == 1) PG8_BAR;
    PG8_WAIT_V(4); PG8_BAR;
    PG8_STAGE(PG8_SB(1, 0), cB + kstep, voffB); PG8_STAGE(PG8_SA(1, 0), cA + kstep, voffA); PG8_STAGE(PG8_SB(1, 1), cB + hstepB + kstep, voffB);
    PG8_WAIT_V(6); PG8_BAR;
    for (;;) {
        const bool has_next = next_unit(d, ui + 1, G, cblk, nxt);
        const char* nA = has_next ? nxt.a : cA; const char* nB = has_next ? nxt.b : cB;
        for (int t = 0; t < nt; t += 2) {
            const bool last = (t == nt - 2);
            const char* a1 = cA + (size_t)(t + 1) * kstep;
            const char* a2 = last ? nA : cA + (size_t)(t + 2) * kstep; const char* b2 = last ? nB : cB + (size_t)(t + 2) * kstep;
            const char* a3 = a2 + kstep; const char* b3 = b2 + kstep;
            PG8_LDB(B0, 0, 0); PG8_SCHED; PG8_LDA(At, 0, 0); PG8_STAGE(PG8_SA(1, 1), a1 + hstepA, voffA);
            PG8_WAIT_L(8); PG8_BAR; PG8_WAIT_L(0); PG8_MMA(0, 0, At, B0); PG8_BAR; PG8_SCHED;
            PG8_LDB(B1, 0, 1); PG8_STAGE(PG8_SB(0, 0), b2, voffB);
            PG8_BAR; PG8_WAIT_L(0); PG8_MMA(0, 1, At, B1); PG8_BAR;
            PG8_LDA(At, 0, 1); PG8_STAGE(PG8_SA(0, 0), a2, voffA);
            PG8_BAR; PG8_WAIT_L(0); PG8_MMA(1, 0, At, B0); PG8_BAR; PG8_SCHED;
            PG8_STAGE(PG8_SB(0, 1), b2 + hstepB, voffB);
            PG8_WAIT_V(6); PG8_BAR; PG8_MMA(1, 1, At, B1); PG8_BAR;
            PG8_LDB(B0, 1, 0); PG8_SCHED; PG8_LDA(At, 1, 0); PG8_STAGE(PG8_SA(0, 1), a2 + hstepA, voffA);
            PG8_WAIT_L(8); PG8_BAR; PG8_WAIT_L(0); PG8_MMA(0, 0, At, B0); PG8_BAR; PG8_SCHED;
            PG8_LDB(B1, 1, 1); PG8_STAGE(PG8_SB(1, 0), b3, voffB);
            PG8_BAR; PG8_WAIT_L(0); PG8_MMA(0, 1, At, B1); PG8_BAR;
            PG8_LDA(At, 1, 1); PG8_STAGE(PG8_SA(1, 0), a3, voffA);
            PG8_BAR; PG8_WAIT_L(0); PG8_MMA(1, 0, At, B0); PG8_BAR; PG8_SCHED;
            PG8_STAGE(PG8_SB(1, 1), b3 + hstepB, voffB);
            PG8_WAIT_V(6); PG8_BAR; PG8_MMA(1, 1, At, B1); PG8_BAR;
        }
        gemm_epilogue(acc, d, cur, wr, wc, fr, fq);
        if (!has_next) break;
#pragma unroll
        for (int a = 0; a < 2; ++a)
#pragma unroll
            for (int b = 0; b < 2; ++b)
#pragma unroll
                for (int m = 0; m < 4; ++m)
#pragma unroll
                    for (int n = 0; n < 2; ++n) acc[a][b][m][n] = (f32x4){0.f, 0.f, 0.f, 0.f};
        cur = nxt; cA = nA; cB = nB; ++ui;
    }
    PG8_WAIT_V(0);
    if (wr == 0) PG8_BAR;
    PG8_BAR;
#undef PG8_SA
#undef PG8_SB
#undef PG8_STAGE
#undef PG8_LDA
#undef PG8_LDB
#undef PG8_MMA
#undef PG8_WAIT_V
#undef PG8_WAIT_L
#undef PG8_BAR
#undef PG8_SCHED
}

namespace att {
constexpr int D = 64, NW = 8, QBLK = 32, KVBLK = 64;
constexpr float SCALE = 0.125f, THR = 8.f;
constexpr int SHM_V = KVBLK * D * 2, SHM_K = KVBLK * D * 2;
constexpr int LDQ = 512, LDK = 128, LDV = 768, LDY = DM;
#define KSWZ(row, colB) ((row) * 128 + ((colB) ^ ((((row) >> 1) & 7) << 4)))
#define SBAR() __builtin_amdgcn_sched_barrier(0)
__device__ __forceinline__ int crow(int r, int hi) { return (r & 3) + 8 * (r >> 2) + 4 * hi; }

__device__ __forceinline__ void partialSM(f32x16& p0, f32x16& p1, float& m_reg, float& mn, float& alpha) {
    constexpr float C = SCALE * 1.4426950408889634f;
    float pmax = p0[0];
#pragma unroll
    for (int r = 1; r < 16; ++r) pmax = fmaxf(pmax, p0[r]);
#pragma unroll
    for (int r = 0; r < 16; ++r) pmax = fmaxf(pmax, p1[r]);
    { auto rr = __builtin_amdgcn_permlane32_swap(__float_as_uint(pmax), __float_as_uint(pmax), false, false);
      pmax = fmaxf(__uint_as_float(rr[0]), __uint_as_float(rr[1])); }
    if (__builtin_expect(__all(pmax - m_reg <= THR / SCALE), 1)) { mn = m_reg; alpha = 1.f; }
    else { mn = fmaxf(m_reg, pmax); alpha = __builtin_amdgcn_exp2f((m_reg - mn) * C); m_reg = mn; }
    const float mnC = -mn * C;
#pragma unroll
    for (int r = 0; r < 16; ++r) p0[r] = fmaf(p0[r], C, mnC);
#pragma unroll
    for (int r = 0; r < 16; ++r) p1[r] = fmaf(p1[r], C, mnC);
#pragma unroll
    for (int r = 0; r < 16; ++r) p0[r] = __builtin_amdgcn_exp2f(p0[r]);
}
__device__ __forceinline__ void finishSM(f32x16& p0, f32x16& p1, float alpha, float& l_reg, bf16x8& pa0, bf16x8& pa1, bf16x8& pa2, bf16x8& pa3) {
#pragma unroll
    for (int r = 0; r < 16; ++r) p1[r] = __builtin_amdgcn_exp2f(p1[r]);
    float ps = 0;
#pragma unroll
    for (int r = 0; r < 16; ++r) ps += p0[r];
#pragma unroll
    for (int r = 0; r < 16; ++r) ps += p1[r];
    { auto rr = __builtin_amdgcn_permlane32_swap(__float_as_uint(ps), __float_as_uint(ps), false, false);
      ps = __uint_as_float(rr[0]) + __uint_as_float(rr[1]); }
    l_reg = l_reg * alpha + ps;
#define PK4(P, BASE, OUT) do { unsigned a0 = cvt_pk_bf16(P[BASE + 0], P[BASE + 1]), a1 = cvt_pk_bf16(P[BASE + 2], P[BASE + 3]);   \
    unsigned b0 = cvt_pk_bf16(P[BASE + 4], P[BASE + 5]), b1 = cvt_pk_bf16(P[BASE + 6], P[BASE + 7]);                              \
    auto r0 = __builtin_amdgcn_permlane32_swap(a0, b0, false, false); auto r1 = __builtin_amdgcn_permlane32_swap(a1, b1, false, false); \
    u32x4 w = {r0[0], r1[0], r0[1], r1[1]}; OUT = *reinterpret_cast<bf16x8*>(&w); } while (0)
    PK4(p0, 0, pa0); PK4(p0, 8, pa1); PK4(p1, 0, pa2); PK4(p1, 8, pa3);
#undef PK4
}
__device__ __forceinline__ void qkt(f32x16& p0, f32x16& p1, const char* Ks, const bf16x8* qr, int r32, int hi) {
    p0 = f32x16{}; p1 = f32x16{};
#pragma unroll
    for (int d0 = 0; d0 < 4; ++d0) { const int cb = (d0 * 16 + hi * 8) * 2;
        bf16x8 b0 = *reinterpret_cast<const bf16x8*>(Ks + KSWZ(r32, cb));
        bf16x8 b1 = *reinterpret_cast<const bf16x8*>(Ks + KSWZ(32 + r32, cb));
        p0 = __builtin_amdgcn_mfma_f32_32x32x16_bf16(b0, qr[d0], p0, 0, 0, 0);
        p1 = __builtin_amdgcn_mfma_f32_32x32x16_bf16(b1, qr[d0], p1, 0, 0, 0); }
}
__device__ __forceinline__ int v_st(int k, int c) { const int kk = (k & ~0xC) | ((k & 4) << 1) | ((k & 8) >> 1); return ((kk >> 3) * 2 + (c >> 5)) * 512 + ((kk & 7) * 32 + (c & 31)) * 2; }
__device__ __forceinline__ int v_rd_base(int lane) { return ((lane & 3) << 3) | (((lane >> 2) & 3) << 6) | (((lane >> 4) & 1) << 5) | (((lane >> 5) & 1) << 8); }
constexpr int v_rd_off(int d0, int ks, int half) { return d0 * 512 + ks * 2048 + half * 1024; }
template <int OFF> __device__ __forceinline__ s16x4 tr_read(int vb) {
    s16x4 r; asm volatile("ds_read_b64_tr_b16 %0, %1 offset:%2" : "=&v"(r) : "v"(vb), "i"(OFF) : "memory"); return r;
}
template <int D0> __device__ __forceinline__ void pv_one(f32x16& od, int vb, bf16x8 pa0, bf16x8 pa1, bf16x8 pa2, bf16x8 pa3) {
    const s16x4 l0 = tr_read<v_rd_off(D0, 0, 0)>(vb), h0 = tr_read<v_rd_off(D0, 0, 1)>(vb), l1 = tr_read<v_rd_off(D0, 1, 0)>(vb), h1 = tr_read<v_rd_off(D0, 1, 1)>(vb);
    const s16x4 l2 = tr_read<v_rd_off(D0, 2, 0)>(vb), h2 = tr_read<v_rd_off(D0, 2, 1)>(vb), l3 = tr_read<v_rd_off(D0, 3, 0)>(vb), h3 = tr_read<v_rd_off(D0, 3, 1)>(vb);
    asm volatile("s_waitcnt lgkmcnt(0)" ::: "memory"); SBAR();
#define PK(L, H) (bf16x8){L[0], L[1], L[2], L[3], H[0], H[1], H[2], H[3]}
    od = __builtin_amdgcn_mfma_f32_32x32x16_bf16(pa0, PK(l0, h0), od, 0, 0, 0);
    od = __builtin_amdgcn_mfma_f32_32x32x16_bf16(pa1, PK(l1, h1), od, 0, 0, 0);
    od = __builtin_amdgcn_mfma_f32_32x32x16_bf16(pa2, PK(l2, h2), od, 0, 0, 0);
    od = __builtin_amdgcn_mfma_f32_32x32x16_bf16(pa3, PK(l3, h3), od, 0, 0, 0);
#undef PK
}
__device__ __forceinline__ void pv_d0(f32x16* o, int vb, bf16x8 pa0, bf16x8 pa1, bf16x8 pa2, bf16x8 pa3) {
    pv_one<0>(o[0], vb, pa0, pa1, pa2, pa3); pv_one<1>(o[1], vb, pa0, pa1, pa2, pa3);
}

__device__ __forceinline__ void attn_body(const bf16_t* __restrict__ Qb, const bf16_t* __restrict__ Kh, const bf16_t* __restrict__ Vh,
                                          bf16_t* __restrict__ Yb, const float* __restrict__ gain, int seq, char* lds) {
    const int tid = otid(), wid = tid >> 6, lane = tid & 63, r32 = lane & 31, hi = lane >> 5;
    char* V_lds = lds; char* K_lds = lds + 2 * SHM_V;
    float* ws = (float*)(lds + 2 * SHM_V + 2 * SHM_K) + wid * 64; float* li_l = ws; float* al_l = ws + 32;
    float m_reg = -1e30f, l_reg = 0; f32x16 o[2] = {}; bf16x8 qr[4];
    const bf16_t* Qw = Qb + (long)(wid * QBLK + r32) * LDQ + hi * 8;
#pragma unroll
    for (int d0 = 0; d0 < 4; ++d0) qr[d0] = *reinterpret_cast<const bf16x8*>(Qw + d0 * 16);
    const int sr = tid >> 3, sc = (tid & 7) * 8, vst0 = v_st(sr, sc), kst0 = KSWZ(sr, sc * 2);
    const int vb0 = (int)(uintptr_t)V_lds + v_rd_base(lane);
    bf16x8 vsE, ksE, vsO, ksO;
#define SLOADE(k0) do { vsE = *reinterpret_cast<const bf16x8*>(&Vh[(long)((k0) + sr) * LDV + sc]); ksE = *reinterpret_cast<const bf16x8*>(&Kh[(long)((k0) + sr) * LDK + sc]); } while (0)
#define SLOADO(k0) do { vsO = *reinterpret_cast<const bf16x8*>(&Vh[(long)((k0) + sr) * LDV + sc]); ksO = *reinterpret_cast<const bf16x8*>(&Kh[(long)((k0) + sr) * LDK + sc]); } while (0)
#define SWRITEE(b) do { *(bf16x8*)(V_lds + (b) * SHM_V + vst0) = vsE; *(bf16x8*)(K_lds + (b) * SHM_K + kst0) = ksE; } while (0)
#define SWRITEO(b) do { *(bf16x8*)(V_lds + (b) * SHM_V + vst0) = vsO; *(bf16x8*)(K_lds + (b) * SHM_K + kst0) = ksO; } while (0)
#define SWAIT() asm volatile("s_waitcnt vmcnt(2)" ::: "memory")
#define RESC(a) do { if (__any((a) < 1.f)) { if (hi == 0) al_l[r32] = (a); asm volatile("s_waitcnt lgkmcnt(0)" ::: "memory"); \
    _Pragma("unroll") for (int dd = 0; dd < 2; ++dd) _Pragma("unroll") for (int r = 0; r < 16; ++r) o[dd][r] *= al_l[crow(r, hi)]; } } while (0)
    f32x16 pA0, pA1, pB0, pB1; float mnA, mnB, alA, alB; bf16x8 pa0, pa1, pa2, pa3; const int NTL = seq / KVBLK;
    SLOADE(0); asm volatile("s_waitcnt vmcnt(0)" ::: "memory"); SWRITEE(0); __syncthreads();
    qkt(pA0, pA1, K_lds, qr, r32, hi); partialSM(pA0, pA1, m_reg, mnA, alA);
    SLOADO(KVBLK); if (2 < NTL) SLOADE(2 * KVBLK);
    SWAIT(); SWRITEO(1); __syncthreads();
    for (int j = 1; j + 1 < NTL; j += 2) {
        SBAR(); qkt(pB0, pB1, K_lds + SHM_K, qr, r32, hi);
        finishSM(pA0, pA1, alA, l_reg, pa0, pa1, pa2, pa3); SBAR();
        SLOADO((j + 2) * KVBLK); SBAR();
        pv_d0(o, vb0, pa0, pa1, pa2, pa3); partialSM(pB0, pB1, m_reg, mnB, alB);
        __syncthreads(); SWAIT(); SWRITEE(0);
        RESC(alB); __syncthreads();
        SBAR(); qkt(pA0, pA1, K_lds, qr, r32, hi);
        finishSM(pB0, pB1, alB, l_reg, pa0, pa1, pa2, pa3); SBAR();
        if (j + 3 < NTL) SLOADE((j + 3) * KVBLK); SBAR();
        pv_d0(o, vb0 + SHM_V, pa0, pa1, pa2, pa3); partialSM(pA0, pA1, m_reg, mnA, alA);
        __syncthreads(); SWAIT(); SWRITEO(1);
        RESC(alA); __syncthreads();
    }
    SBAR(); qkt(pB0, pB1, K_lds + SHM_K, qr, r32, hi);
    finishSM(pA0, pA1, alA, l_reg, pa0, pa1, pa2, pa3); SBAR();
    pv_d0(o, vb0, pa0, pa1, pa2, pa3); partialSM(pB0, pB1, m_reg, mnB, alB);
    __syncthreads(); RESC(alB);
    finishSM(pB0, pB1, alB, l_reg, pa0, pa1, pa2, pa3); SBAR();
    pv_d0(o, vb0 + SHM_V, pa0, pa1, pa2, pa3);
    if (hi == 0) li_l[r32] = l_reg; asm volatile("s_waitcnt lgkmcnt(0)" ::: "memory");
    const float g0 = gain[r32], g1 = gain[32 + r32];
    bf16_t* Yw = Yb + (long)(wid * QBLK) * LDY;
#pragma unroll
    for (int r = 0; r < 16; ++r) {
        const int orow = crow(r, hi);
        const float rl = __builtin_amdgcn_rcpf(li_l[orow]);
        const float a = o[0][r] * rl, b = o[1][r] * rl;
        float ss = a * a + b * b;
        ss = sum16(ss); ss += __shfl_xor(ss, 16);
        const float rs = rsqrtf(ss * (1.f / 64.f) + LN_EPS);
        const unsigned wa = cvt_pk_bf16(a * rs * g0, b * rs * g1);
        Yw[(long)orow * LDY + r32] = (bf16_t)(wa & 0xffffu);
        Yw[(long)orow * LDY + 32 + r32] = (bf16_t)(wa >> 16);
    }
    __syncthreads();
#undef SLOADE
#undef SLOADO
#undef SWRITEE
#undef SWRITEO
#undef SWAIT
#undef RESC
}
}

__device__ __forceinline__ void ln_rows(const float* src, float* dstf, bf16_t* dstb, const float* __restrict__ g, const float* __restrict__ b) {
    const int tid = otid(), lane = tid & 63, wid = tid >> 6;
    const int nw = ogrid() * 8;
    f32x4 gv[4], bv[4];
#pragma unroll
    for (int j = 0; j < 4; ++j) { gv[j] = *(const f32x4*)(g + j * 256 + lane * 4); bv[j] = *(const f32x4*)(b + j * 256 + lane * 4); }
    for (int row0 = obid() * 8 + wid; row0 < MTOK; row0 += 2 * nw) {
        f32x4 v[2][4];
#pragma unroll
        for (int u = 0; u < 2; ++u) { const int row = row0 + u * nw; const float* sp = src + (size_t)(row < MTOK ? row : row0) * DM;
#pragma unroll
            for (int j = 0; j < 4; ++j) v[u][j] = *(const f32x4*)(sp + j * 256 + lane * 4); }
#pragma unroll
        for (int u = 0; u < 2; ++u) {
            const int row = row0 + u * nw; if (row >= MTOK) break;
            float s = 0.f;
#pragma unroll
            for (int j = 0; j < 4; ++j) s += v[u][j][0] + v[u][j][1] + v[u][j][2] + v[u][j][3];
            const float mean = wave_sum(s) * (1.f / DM);
            float q = 0.f;
#pragma unroll
            for (int j = 0; j < 4; ++j) { v[u][j] -= mean; q += v[u][j][0] * v[u][j][0] + v[u][j][1] * v[u][j][1] + v[u][j][2] * v[u][j][2] + v[u][j][3] * v[u][j][3]; }
            const float rstd = rsqrtf(wave_sum(q) * (1.f / DM) + LN_EPS);
#pragma unroll
            for (int j = 0; j < 4; ++j) {
                const f32x4 y = v[u][j] * rstd * gv[j] + bv[j];
                if (dstf) *(f32x4*)(dstf + (size_t)row * DM + j * 256 + lane * 4) = y;
                if (dstb) { u32x2 w; w.x = cvt_pk_bf16(y[0], y[1]); w.y = cvt_pk_bf16(y[2], y[3]); *(u32x2*)(dstb + (size_t)row * DM + j * 256 + lane * 4) = w; }
            }
        }
    }
}

constexpr int TLD = 257;
__device__ __forceinline__ void transpose_tile(const float* __restrict__ W, bf16_t* __restrict__ Wt, int K, int N, int tile, float* tl, bool glu) {
    const int tn = N >> 8; const int k0 = (tile / tn) * 64, n0 = (tile % tn) * 256; const int tid = otid();
    f32x4 v[8];
#pragma unroll
    for (int i = 0; i < 8; ++i) { const int q = tid + i * NTHR, kk = q >> 6, n4 = (q & 63) * 4;
        int ns = n0 + n4;
        if (glu && n0 >= 768) { const int blk = (n0 - 768) >> 8; ns = (n4 < 128) ? 768 + blk * 128 + n4 : 1280 + blk * 128 + (n4 - 128); }
        v[i] = *(const f32x4*)(W + (size_t)(k0 + kk) * N + ns); }
#pragma unroll
    for (int i = 0; i < 8; ++i) { const int q = tid + i * NTHR, kk = q >> 6, n4 = (q & 63) * 4; float* d = tl + kk * TLD + n4; d[0] = v[i][0]; d[1] = v[i][1]; d[2] = v[i][2]; d[3] = v[i][3]; }
    __syncthreads();
#pragma unroll
    for (int i = 0; i < 4; ++i) { const int q = tid + i * NTHR, nn = q >> 3, kc = (q & 7) * 8; float x[8];
#pragma unroll
        for (int j = 0; j < 8; ++j) x[j] = tl[(kc + j) * TLD + nn];
        u32x4 w; w.x = cvt_pk_bf16(x[0], x[1]); w.y = cvt_pk_bf16(x[2], x[3]); w.z = cvt_pk_bf16(x[4], x[5]); w.w = cvt_pk_bf16(x[6], x[7]);
        *(u32x4*)(Wt + (size_t)(n0 + nn) * K + k0 + kc) = w; }
    __syncthreads();
}

__device__ __forceinline__ void phase_prep(const Params& p, char* lds) {
    unsigned char* ws = p.ws; float* tl = (float*)lds;
    constexpr int T0 = 112, T1 = T0 + 64, T2 = T1 + 64, T3 = T2 + 128, T4 = T3 + 64, T5 = T4 + 256, T6 = T5 + 256;
    for (int t = blockIdx.x; t < T6; t += gridDim.x) {
        if (t < T0) transpose_tile(p.in[4], (bf16_t*)(ws + OFF_WIN), DM, INC, t, tl, true);
        else if (t < T1) transpose_tile(p.in[13], (bf16_t*)(ws + OFF_WOUT), DM, DM, t - T0, tl, false);
        else if (t < T2) transpose_tile(p.in[16], (bf16_t*)(ws + OFF_WMQ), DM, DM, t - T1, tl, false);
        else if (t < T3) transpose_tile(p.in[17], (bf16_t*)(ws + OFF_WMKV), DM, 2 * DM, t - T2, tl, false);
        else if (t < T4) transpose_tile(p.in[18], (bf16_t*)(ws + OFF_WMO), DM, DM, t - T3, tl, false);
        else if (t < T5) transpose_tile(p.in[21], (bf16_t*)(ws + OFF_WFF1), DM, DFF, t - T4, tl, false);
        else transpose_tile(p.in[23], (bf16_t*)(ws + OFF_WFF2), DFF, DM, t - T5, tl, false);
    }
    { float* sm = (float*)(ws + OFF_SMALL); const int gt = blockIdx.x * NTHR + threadIdx.x, gs = gridDim.x * NTHR;
#define CPY(idx, off, n) for (int i = gt; i < (n); i += gs) sm[(off) + i] = p.in[idx][i];
      CPY(5, SM_QG, 64) CPY(6, SM_KG, 64) CPY(7, SM_CONVW, 31 * 512) CPY(8, SM_CONVB, 512) CPY(9, SM_CLNG, 512) CPY(10, SM_CLNB, 512)
      CPY(11, SM_AOG, 512) CPY(12, SM_COG, 512) CPY(14, SM_LN1G, 1024) CPY(15, SM_LN1B, 1024) CPY(19, SM_LN2G, 1024) CPY(20, SM_LN2B, 1024)
      CPY(22, SM_BFF1, 4096) CPY(24, SM_BFF2, 1024) CPY(25, SM_LN3G, 1024) CPY(26, SM_LN3B, 1024)
#undef CPY
    }
    ln_rows(p.in[0], (float*)(ws + OFF_A), (bf16_t*)(ws + OFF_B), p.in[2], p.in[3]);
    { const float* mem = p.in[1]; bf16_t* mb = (bf16_t*)(ws + OFF_MEMB);
      for (size_t i = ((size_t)blockIdx.x * NTHR + threadIdx.x) * 8; i < (size_t)MMEM * DM; i += (size_t)gridDim.x * NTHR * 8) {
          const f32x4 a = *(const f32x4*)(mem + i), b = *(const f32x4*)(mem + i + 4);
          u32x4 w; w.x = cvt_pk_bf16(a[0], a[1]); w.y = cvt_pk_bf16(a[2], a[3]); w.z = cvt_pk_bf16(b[0], b[1]); w.w = cvt_pk_bf16(b[2], b[3]);
          *(u32x4*)(mb + i) = w; } }
}

__device__ __forceinline__ void qk_chunk(const u32x4 raw, long g, const float* qg, const float* kg, bf16_t* qR, bf16_t* kR) {
    const int tok = (int)(g / 80), ch = (int)(g % 80), head = ch >> 3, part = ch & 7;
    float x[8]; x[0] = bflo(raw.x); x[1] = bfhi(raw.x); x[2] = bflo(raw.y); x[3] = bfhi(raw.y); x[4] = bflo(raw.z); x[5] = bfhi(raw.z); x[6] = bflo(raw.w); x[7] = bfhi(raw.w);
    float ss = 0.f;
#pragma unroll
    for (int j = 0; j < 8; ++j) ss += x[j] * x[j];
    ss = sum8(ss);
    const float rs = rsqrtf(ss * (1.f / 64.f) + LN_EPS);
    const float* gp = (head < 8 ? qg : kg) + part * 8;
    const f32x4 ga = *(const f32x4*)gp, gb = *(const f32x4*)(gp + 4);
    x[0] *= rs * ga[0]; x[1] *= rs * ga[1]; x[2] *= rs * ga[2]; x[3] *= rs * ga[3];
    x[4] *= rs * gb[0]; x[5] *= rs * gb[1]; x[6] *= rs * gb[2]; x[7] *= rs * gb[3];
    const int s = tok & (SEQ - 1);
    const float pos = (float)((part < 4) ? (s >> 6) : (s & 63));
    float y[8];
#pragma unroll
    for (int jj = 0; jj < 4; ++jj) {
        const int fi = (part & 3) * 4 + jj;
        const float inv = exp2f(-(float)fi * (13.287712379549449f / 16.f));
        const float ang = pos * inv;
        float sn, cs; __sincosf(ang, &sn, &cs);
        y[2 * jj] = x[2 * jj] * cs - x[2 * jj + 1] * sn;
        y[2 * jj + 1] = x[2 * jj] * sn + x[2 * jj + 1] * cs;
    }
    u32x4 w; w.x = cvt_pk_bf16(y[0], y[1]); w.y = cvt_pk_bf16(y[2], y[3]); w.z = cvt_pk_bf16(y[4], y[5]); w.w = cvt_pk_bf16(y[6], y[7]);
    if (head < 8) *(u32x4*)(qR + (size_t)tok * 512 + head * 64 + part * 8) = w;
    else *(u32x4*)(kR + (size_t)tok * 128 + (head - 8) * 64 + part * 8) = w;
}
__device__ __forceinline__ void phase_qk(const Params& p) {
    const bf16_t* proj = (const bf16_t*)(p.ws + OFF_T);
    bf16_t* qR = (bf16_t*)(p.ws + OFF_Q); bf16_t* kR = (bf16_t*)(p.ws + OFF_KR);
    const float* sm = (const float*)(p.ws + OFF_SMALL); const float* qg = sm + SM_QG; const float* kg = sm + SM_KG;
    const long total = (long)MTOK * 80, stride = (long)ogrid() * NTHR;
    for (long g0 = (long)obid() * NTHR + otid(); g0 < total; g0 += 5 * stride) {
        u32x4 raw[5];
#pragma unroll
        for (int k = 0; k < 5; ++k) { const long g = g0 + k * stride; raw[k] = (u32x4){0u, 0u, 0u, 0u};
            if (g < total) { const int tok = (int)(g / 80), ch = (int)(g % 80), head = ch >> 3, part = ch & 7; const int col = (head < 8) ? head * 64 : 512 + (head - 8) * 64;
                raw[k] = *(const u32x4*)(proj + (size_t)tok * 768 + col + part * 8); } }
#pragma unroll
        for (int k = 0; k < 5; ++k) { const long g = g0 + k * stride; if (g < total) qk_chunk(raw[k], g, qg, kg, qR, kR); }
    }
}

constexpr int CT = 32, CROWS = CT + 30;
__device__ __forceinline__ void phase_conv(const Params& p, char* lds) {
    const bf16_t* Ug = (const bf16_t*)(p.ws + OFF_U);
    bf16_t* Y = (bf16_t*)(p.ws + OFF_Y);
    const float* sm = (const float*)(p.ws + OFF_SMALL);
    bf16_t* Ub = (bf16_t*)lds;
    float* Z = (float*)(lds + CROWS * 512 * 2);
    static_assert(CROWS * 512 * 2 + CT * 512 * 4 <= LDS_MAIN, "conv LDS");
    const int tid = otid(), c = tid, lane = tid & 63, wid = tid >> 6;
    float w[31];
#pragma unroll
    for (int j = 0; j < 31; ++j) w[j] = sm[SM_CONVW + j * 512 + c];
    const float cb = sm[SM_CONVB + c];
    const f32x4 lg0 = *(const f32x4*)(sm + SM_CLNG + lane * 8), lg1 = *(const f32x4*)(sm + SM_CLNG + lane * 8 + 4);
    const f32x4 lb0 = *(const f32x4*)(sm + SM_CLNB + lane * 8), lb1 = *(const f32x4*)(sm + SM_CLNB + lane * 8 + 4);
    const f32x4 og0 = *(const f32x4*)(sm + SM_COG + lane * 8), og1 = *(const f32x4*)(sm + SM_COG + lane * 8 + 4);
    for (int tile = obid(); tile < MTOK / CT; tile += ogrid()) {
        const int tok0 = tile * CT, bb = tok0 / SEQ, s0 = tok0 % SEQ;
        { u32x4 sv[8];
#pragma unroll
          for (int i = 0; i < 8; ++i) { const int q = tid + i * NTHR, r = q >> 6, c8 = (q & 63) * 8; const int s = s0 - 15 + r;
              sv[i] = (u32x4){0u, 0u, 0u, 0u};
              if (q < CROWS * 64 && s >= 0 && s < SEQ) sv[i] = *(const u32x4*)(Ug + (size_t)(bb * SEQ + s) * 512 + c8); }
#pragma unroll
          for (int i = 0; i < 8; ++i) { const int q = tid + i * NTHR, r = q >> 6, c8 = (q & 63) * 8;
              if (q < CROWS * 64) *(u32x4*)(Ub + r * 512 + c8) = sv[i]; } }
        __syncthreads();
        {
            float uw[CROWS];
#pragma unroll
            for (int r = 0; r < CROWS; ++r) uw[r] = bf2f(Ub[r * 512 + c]);
#pragma unroll
            for (int t = 0; t < CT; ++t) {
                float a = cb;
#pragma unroll
                for (int j = 0; j < 31; ++j) a = fmaf(uw[t + j], w[j], a);
                Z[t * 512 + c] = a;
            }
        }
        __syncthreads();
#pragma unroll
        for (int k = 0; k < 4; ++k) {
            const int t = wid * 4 + k;
            f32x4 x0 = *(const f32x4*)(Z + t * 512 + lane * 8), x1 = *(const f32x4*)(Z + t * 512 + lane * 8 + 4);
            float s1 = (x0[0] + x0[1]) + (x0[2] + x0[3]) + (x1[0] + x1[1]) + (x1[2] + x1[3]);
            float s2 = x0[0] * x0[0] + x0[1] * x0[1] + x0[2] * x0[2] + x0[3] * x0[3] + x1[0] * x1[0] + x1[1] * x1[1] + x1[2] * x1[2] + x1[3] * x1[3];
            s1 = wave_sum(s1); s2 = wave_sum(s2);
            const float mean = s1 * (1.f / 512.f); const float var = fmaxf(s2 * (1.f / 512.f) - mean * mean, 0.f); const float rstd = rsqrtf(var + LN_EPS);
            f32x4 y0 = (x0 - mean) * rstd * lg0 + lb0, y1 = (x1 - mean) * rstd * lg1 + lb1;
            float gs = 0.f;
#pragma unroll
            for (int j = 0; j < 4; ++j) { y0[j] *= sigmoidf_(y0[j]); y1[j] *= sigmoidf_(y1[j]); gs += y0[j] * y0[j] + y1[j] * y1[j]; }
            gs = sum8(gs);
            const float rs = rsqrtf(gs * (1.f / 64.f) + LN_EPS);
            y0 = y0 * rs * og0; y1 = y1 * rs * og1;
            u32x4 wv; wv.x = cvt_pk_bf16(y0[0], y0[1]); wv.y = cvt_pk_bf16(y0[2], y0[3]); wv.z = cvt_pk_bf16(y1[0], y1[1]); wv.w = cvt_pk_bf16(y1[2], y1[3]);
            *(u32x4*)(Y + (size_t)(tok0 + t) * DM + 512 + lane * 8) = wv;
        }
    }
    __syncthreads();
}

__device__ __forceinline__ void phase_attn(const Params& p, char* lds) {
    const bf16_t* proj = (const bf16_t*)(p.ws + OFF_T);
    const bf16_t* qR = (const bf16_t*)(p.ws + OFF_Q); const bf16_t* kR = (const bf16_t*)(p.ws + OFF_KR);
    bf16_t* Y = (bf16_t*)(p.ws + OFF_Y);
    for (int item = obid(); item < BATCH * 8 * (SEQ / 256); item += ogrid()) {
        const int qb = item & 7, h = (item >> 3) & 7, b = item >> 6, kvh = h >> 2;
        const size_t tok0 = (size_t)b * SEQ;
        att::attn_body(qR + (tok0 + qb * 256) * 512 + h * 64, kR + tok0 * 128 + kvh * 64, proj + tok0 * 768 + 640 + kvh * 64,
                       Y + (tok0 + qb * 256) * DM + h * 64, (const float*)(p.ws + OFF_SMALL) + SM_AOG + h * 64, SEQ, lds);
    }
}

__device__ __forceinline__ void phase_softmax(const Params& p) {
    const float* Sc = (const float*)(p.ws + OFF_T); bf16_t* P = (bf16_t*)(p.ws + OFF_Y);
    const int tid = otid(), lane = tid & 63, wid = tid >> 6; const int nw = ogrid() * 8;
    for (int row = obid() * 8 + wid; row < MTOK; row += nw) {
#pragma unroll
        for (int h = 0; h < 4; ++h) {
            const f32x4 v = *(const f32x4*)(Sc + (size_t)row * DM + h * 256 + lane * 4);
            const float mx = wave_max(fmaxf(fmaxf(v[0], v[1]), fmaxf(v[2], v[3])));
            const float e0 = __expf(v[0] - mx), e1 = __expf(v[1] - mx), e2 = __expf(v[2] - mx), e3 = __expf(v[3] - mx);
            const float inv = 1.f / wave_sum(e0 + e1 + e2 + e3);
            u32x2 w; w.x = cvt_pk_bf16(e0 * inv, e1 * inv); w.y = cvt_pk_bf16(e2 * inv, e3 * inv);
            *(u32x2*)(P + (size_t)row * DM + h * 256 + lane * 4) = w;
        }
    }
}

__device__ __forceinline__ GemmDesc plain_gemm(const bf16_t* A, int lda, const bf16_t* Bt, int ldb, int M, int N, int K, int shift,
                                               int kind, void* out, int ldc, const float* bias, float scale, int act, float alpha) {
    GemmDesc d; d.A = A; d.Bt = Bt; d.lda = lda; d.ldb = ldb; d.K = K; d.nM = M / BM; d.nN = N / BM; d.nZ = 1; d.zdiv = 1;
    d.sA0 = d.sA1 = d.sB0 = d.sB1 = 0; d.rz0 = 0; d.cz1 = 0; d.shift = shift; d.kind = kind; d.out = out; d.out2 = nullptr; d.ldc = ldc; d.bias = bias; d.scale = scale; d.act = act; d.alpha = alpha;
    return d;
}

enum { PH_PREP = 0, PH_G1, PH_QKCONV, PH_ATTN, PH_G2, PH_LN1, PH_G3, PH_G4, PH_SOFTMAX, PH_G5, PH_G6, PH_LN2, PH_G7, PH_G8, PH_LN3, PH_COUNT };

__device__ __forceinline__ int gemm_count(int ph) {
    switch (ph) { case PH_G1: return 3; case PH_G2: case PH_G3: case PH_G4: case PH_G5: case PH_G6: case PH_G7: case PH_G8: return 1; default: return 0; }
}
__device__ __forceinline__ GemmDesc make_desc(const Params& p, int ph, int gi) {
    unsigned char* ws = p.ws;
    const bf16_t* Bh = (const bf16_t*)(ws + OFF_B);
    switch (ph) {
    case PH_G1:
        if (gi == 0) { GemmDesc d = plain_gemm(Bh, DM, (const bf16_t*)(ws + OFF_WIN), DM, MTOK, INC, DM, 0, 2, ws + OFF_T, 768, nullptr, 1.f, 0, 0.f); d.out2 = ws + OFF_U; return d; }
        if (gi == 1) return plain_gemm((const bf16_t*)(ws + OFF_MEMB), DM, (const bf16_t*)(ws + OFF_WMKV), DM, MMEM, DM, DM, 192, 0, ws + OFF_MEMK, DM, nullptr, 1.f, 0, 0.f);
        return plain_gemm((const bf16_t*)(ws + OFF_WMKV) + (size_t)DM * DM, DM, (const bf16_t*)(ws + OFF_MEMB), DM, DM, MMEM, DM, 224, 0, ws + OFF_MEMVT, MMEM, nullptr, 1.f, 0, 0.f);
    case PH_G2:
        return plain_gemm((const bf16_t*)(ws + OFF_Y), DM, (const bf16_t*)(ws + OFF_WOUT), DM, MTOK, DM, DM, 0, 1, ws + OFF_A, DM, nullptr, 1.f, 0, ALPHA);
    case PH_G3:
        return plain_gemm(Bh, DM, (const bf16_t*)(ws + OFF_WMQ), DM, MTOK, DM, DM, 0, 0, ws + OFF_Y, DM, nullptr, 1.f, 0, 0.f);
    case PH_G4: {
        GemmDesc d = plain_gemm((const bf16_t*)(ws + OFF_Y), DM, (const bf16_t*)(ws + OFF_MEMK), DM, SEQ, NMEM, 256, 0, 1, ws + OFF_T, DM, nullptr, 0.0625f, 0, 0.f);
        d.nZ = BATCH * 4; d.zdiv = 4; d.sA0 = (long)SEQ * DM; d.sA1 = 256; d.sB0 = (long)NMEM * DM; d.sB1 = 256; d.rz0 = SEQ; d.cz1 = 256; return d; }
    case PH_G5: {
        GemmDesc d = plain_gemm((const bf16_t*)(ws + OFF_Y), DM, (const bf16_t*)(ws + OFF_MEMVT), MMEM, SEQ, 256, 256, 0, 0, ws + OFF_T, DM, nullptr, 1.f, 0, 0.f);
        d.nZ = BATCH * 4; d.zdiv = 4; d.sA0 = (long)SEQ * DM; d.sA1 = 256; d.sB0 = NMEM; d.sB1 = (long)256 * MMEM; d.rz0 = SEQ; d.cz1 = 256; return d; }
    case PH_G6:
        return plain_gemm((const bf16_t*)(ws + OFF_T), DM, (const bf16_t*)(ws + OFF_WMO), DM, MTOK, DM, DM, 0, 1, ws + OFF_A, DM, nullptr, 1.f, 0, ALPHA);
    case PH_G7:
        return plain_gemm(Bh, DM, (const bf16_t*)(ws + OFF_WFF1), DM, MTOK, DFF, DM, 0, 0, ws + OFF_A1, DFF, (const float*)(ws + OFF_SMALL) + SM_BFF1, 1.f, 1, 0.f);
    default:
        return plain_gemm((const bf16_t*)(ws + OFF_A1), DFF, (const bf16_t*)(ws + OFF_WFF2), DFF, MTOK, DM, DFF, 0, 1, ws + OFF_A, DM, (const float*)(ws + OFF_SMALL) + SM_BFF2, 1.f, 0, ALPHA);
    }
}

#ifdef PROBE_TS
#define TS_STAMP(k) do { if (blockIdx.x == 0 && threadIdx.x == 0) ((volatile unsigned long long*)(ws + OFF_TS))[k] = __builtin_amdgcn_s_memrealtime(); } while (0)
#else
#define TS_STAMP(k) do { } while (0)
#endif
__global__ void __launch_bounds__(NTHR) mega(Params p) {
    extern __shared__ __attribute__((aligned(16))) unsigned char lds_raw[];
    cg::grid_group grid = cg::this_grid();
    unsigned char* ws = p.ws;
    volatile LAS unsigned* bst = (volatile LAS unsigned*)((LAS unsigned char*)lds_raw + LDS_MAIN);
    if (threadIdx.x < 4) bst[threadIdx.x] = 0u;
    __syncthreads();
    const XcdBarrier xb = xcd_barrier_post((unsigned*)(ws + OFF_BAR), bst);
    if (p.ph_lo < 0) grid.sync();
    TS_STAMP(0);
    int ph0 = p.ph_lo;
    if (ph0 == PH_PREP) {
        phase_prep(p, (char*)lds_raw);
#ifdef REPEAT_MASK
        if (REPEAT_MASK & 1) phase_prep(p, (char*)lds_raw);
#endif
        if (1 < p.ph_hi) xcd_barrier(xb);
        TS_STAMP(1);
        ph0 = 1;
    }
#pragma nounroll
    for (int ph = ph0; ph < p.ph_hi; ++ph) {
#ifdef REPEAT_MASK
#pragma nounroll
      for (int rep = 0; rep < (((REPEAT_MASK >> ph) & 1) ? 2 : 1); ++rep) {
#else
      {
#endif
        const int ng = gemm_count(ph);
        if (ng > 0) {
#pragma nounroll
            for (int gi = 0; gi < ng; ++gi) { const GemmDesc d = make_desc(p, ph, gi); gemm_phase((LAS unsigned char*)lds_raw, d); }
        } else if (ph == PH_QKCONV) {
            phase_qk(p);
            phase_conv(p, (char*)lds_raw);
        } else if (ph == PH_ATTN) {
            phase_attn(p, (char*)lds_raw);
        } else if (ph == PH_LN1) {
            ln_rows((const float*)(ws + OFF_A), (float*)(ws + OFF_A), (bf16_t*)(ws + OFF_B), (const float*)(ws + OFF_SMALL) + SM_LN1G, (const float*)(ws + OFF_SMALL) + SM_LN1B);
        } else if (ph == PH_SOFTMAX) {
            phase_softmax(p);
        } else if (ph == PH_LN2) {
            ln_rows((const float*)(ws + OFF_A), (float*)(ws + OFF_A), (bf16_t*)(ws + OFF_B), (const float*)(ws + OFF_SMALL) + SM_LN2G, (const float*)(ws + OFF_SMALL) + SM_LN2B);
        } else if (ph == PH_LN3) {
            ln_rows((const float*)(ws + OFF_A), p.out, nullptr, (const float*)(ws + OFF_SMALL) + SM_LN3G, (const float*)(ws + OFF_SMALL) + SM_LN3B);
        }
      }
        if (ph + 1 < p.ph_hi) xcd_barrier(xb);
        TS_STAMP(ph + 1);
    }
#ifdef PROBE_TS
    xcd_barrier(xb);
    if (blockIdx.x == 0) {
        const volatile unsigned long long* ts = (const volatile unsigned long long*)(ws + OFF_TS);
        const float da = (float)(ts[PROBE_A_HI + 1] - ts[PROBE_A_LO]) * 0.01f, db = (float)(ts[PROBE_B_HI + 1] - ts[PROBE_B_LO]) * 0.01f;
        for (int i = threadIdx.x; i < MTOK * DM; i += NTHR) p.out[i] = (i == 0) ? da * 1000.f : db;
    }
#endif
}

extern "C" void kernel_launch(void* const* d_in, const int* in_sizes, int n_in, void* d_out, int out_size, void* d_ws, size_t ws_size, hipStream_t stream) {
    static int grid = 0;
    if (grid == 0) {
        if (n_in != 27 || ws_size < WS_END) { fprintf(stderr, "kernel_launch: unexpected n_in %d / ws_size %zu (need %zu)\n", n_in, ws_size, (size_t)WS_END); grid = -1; return; }
        int dev = 0, cus = 0, per_cu = 0;
        (void)hipGetDevice(&dev);
        (void)hipDeviceGetAttribute(&cus, hipDeviceAttributeMultiprocessorCount, dev);
        if (hipFuncSetAttribute((const void*)mega, hipFuncAttributeMaxDynamicSharedMemorySize, LDS_BYTES) != hipSuccess) { fprintf(stderr, "kernel_launch: hipFuncSetAttribute failed\n"); grid = -1; return; }
        if (hipOccupancyMaxActiveBlocksPerMultiprocessor(&per_cu, (const void*)mega, NTHR, LDS_BYTES) != hipSuccess || per_cu < 1) { fprintf(stderr, "kernel_launch: occupancy query says %d\n", per_cu); per_cu = 1; }
        (void)hipGetLastError();
        grid = cus * per_cu;
        fprintf(stderr, "kernel_launch: grid %d (cus %d x %d)\n", grid, cus, per_cu);
    }
    if (grid < 0) return;
    Params p{};
    for (int i = 0; i < 27; ++i) p.in[i] = (const float*)d_in[i];
    p.out = (float*)d_out; p.ws = (unsigned char*)d_ws; p.ph_lo = 0; p.ph_hi = PH_COUNT;
    if (hipMemsetAsync((char*)d_ws + OFF_BAR, 0, BAR_BYTES, stream) != hipSuccess) { fprintf(stderr, "kernel_launch: memset failed\n"); return; }
    void* args[] = {&p};
    hipError_t e = hipLaunchCooperativeKernel((const void*)mega, dim3(grid), dim3(NTHR), args, LDS_BYTES, stream);
    if (e != hipSuccess) fprintf(stderr, "kernel_launch: cooperative launch failed: %s (grid %d)\n", hipGetErrorString(e), grid);
}
```

```cpp
#include <hip/hip_runtime.h>
#include <hip/hip_cooperative_groups.h>
#include <cstdio>
#include <cstdint>
namespace cg = cooperative_groups;

#define LAS __attribute__((address_space(3)))
typedef unsigned short bf16_t;
typedef short bf16x8 __attribute__((ext_vector_type(8)));
typedef short s16x4 __attribute__((ext_vector_type(4)));
typedef float f32x4 __attribute__((ext_vector_type(4)));
typedef float f32x16 __attribute__((ext_vector_type(16)));
typedef unsigned u32x4 __attribute__((ext_vector_type(4)));
typedef unsigned u32x2 __attribute__((ext_vector_type(2)));

constexpr int NTHR = 512;
constexpr int BATCH = 8, SEQ = 2048, DM = 1024, MTOK = BATCH * SEQ, NMEM = 256, MMEM = BATCH * NMEM, DFF = 4096, INC = 1792;
constexpr float LN_EPS = 1e-5f;
constexpr float ALPHA = 1.189207115002721f;
constexpr int LDS_MAIN = 131072;
constexpr int LDS_BYTES = LDS_MAIN + 16;

constexpr size_t MiB = 1024 * 1024;
constexpr size_t OFF_WIN = 0;
constexpr size_t OFF_WOUT = OFF_WIN + (size_t)INC * DM * 2;
constexpr size_t OFF_WMQ = OFF_WOUT + (size_t)DM * DM * 2;
constexpr size_t OFF_WMKV = OFF_WMQ + (size_t)DM * DM * 2;
constexpr size_t OFF_WMO = OFF_WMKV + (size_t)2 * DM * DM * 2;
constexpr size_t OFF_WFF1 = OFF_WMO + (size_t)DM * DM * 2;
constexpr size_t OFF_WFF2 = OFF_WFF1 + (size_t)DFF * DM * 2;
constexpr size_t OFF_A = OFF_WFF2 + (size_t)DFF * DM * 2;
constexpr size_t OFF_B = OFF_A + 64 * MiB;
constexpr size_t OFF_REST = OFF_B + 32 * MiB;
constexpr size_t OFF_MEMB = OFF_REST;
constexpr size_t OFF_MEMK = OFF_REST + 4 * MiB;
constexpr size_t OFF_MEMVT = OFF_REST + 8 * MiB;
constexpr size_t OFF_T = OFF_REST + 12 * MiB;
constexpr size_t OFF_U = OFF_T + 24 * MiB;
constexpr size_t OFF_Y = OFF_T + 64 * MiB;
constexpr size_t OFF_Q = OFF_Y + 32 * MiB;
constexpr size_t OFF_KR = OFF_Q + 16 * MiB;
constexpr size_t OFF_A1 = OFF_REST;
constexpr size_t OFF_SMALL = OFF_REST + 128 * MiB;
constexpr size_t OFF_BAR = OFF_SMALL + 128 * 1024;
constexpr size_t BAR_BYTES = 16384;
constexpr size_t OFF_TS = OFF_BAR + BAR_BYTES;
constexpr size_t WS_END = OFF_TS + 1024;
constexpr int SM_QG = 0, SM_KG = 64, SM_CONVW = 128, SM_CONVB = SM_CONVW + 31 * 512, SM_CLNG = SM_CONVB + 512, SM_CLNB = SM_CLNG + 512,
              SM_AOG = SM_CLNB + 512, SM_COG = SM_AOG + 512, SM_LN1G = SM_COG + 512, SM_LN1B = SM_LN1G + 1024, SM_LN2G = SM_LN1B + 1024,
              SM_LN2B = SM_LN2G + 1024, SM_BFF1 = SM_LN2B + 1024, SM_BFF2 = SM_BFF1 + 4096, SM_LN3G = SM_BFF2 + 1024, SM_LN3B = SM_LN3G + 1024,
              SM_END = SM_LN3B + 1024;
static_assert(SM_END * 4 <= 128 * 1024, "small block");

struct Params {
    const float* in[27];
    float* out;
    unsigned char* ws;
    int ph_lo, ph_hi;
};

__device__ __forceinline__ unsigned cvt_pk_bf16(float lo, float hi) { unsigned r; asm volatile("v_cvt_pk_bf16_f32 %0, %1, %2" : "=v"(r) : "v"(lo), "v"(hi)); return r; }
__device__ __forceinline__ float bf2f(unsigned short b) { return __uint_as_float(((unsigned)b) << 16); }
__device__ __forceinline__ float bflo(unsigned w) { return __uint_as_float(w << 16); }
__device__ __forceinline__ float bfhi(unsigned w) { return __uint_as_float(w & 0xffff0000u); }
template <int CTRL> __device__ __forceinline__ float dpp_f(float v) { return __int_as_float(__builtin_amdgcn_update_dpp(0, __float_as_int(v), CTRL, 0xF, 0xF, true)); }
__device__ __forceinline__ float rdlane(float v, int l) { return __int_as_float(__builtin_amdgcn_readlane(__float_as_int(v), l)); }
__device__ __forceinline__ float sum8(float v) { v += dpp_f<0xB1>(v); v += dpp_f<0x4E>(v); v += dpp_f<0x141>(v); return v; }
__device__ __forceinline__ float sum16(float v) { v = sum8(v); v += dpp_f<0x140>(v); return v; }
__device__ __forceinline__ float wave_sum(float v) { v = sum16(v); return (rdlane(v, 0) + rdlane(v, 16)) + (rdlane(v, 32) + rdlane(v, 48)); }
__device__ __forceinline__ float wave_max(float v) {
    v = fmaxf(v, dpp_f<0xB1>(v)); v = fmaxf(v, dpp_f<0x4E>(v)); v = fmaxf(v, dpp_f<0x141>(v)); v = fmaxf(v, dpp_f<0x140>(v));
    return fmaxf(fmaxf(rdlane(v, 0), rdlane(v, 16)), fmaxf(rdlane(v, 32), rdlane(v, 48)));
}
__device__ __forceinline__ int otid() { int t = threadIdx.x; asm volatile("" : "+v"(t)); return t; }
__device__ __forceinline__ int obid() { int t = blockIdx.x; asm volatile("" : "+s"(t)); return t; }
__device__ __forceinline__ int ogrid() { int t = gridDim.x; asm volatile("" : "+s"(t)); return t; }
__device__ __forceinline__ float sigmoidf_(float x) { return __builtin_amdgcn_rcpf(1.f + __expf(-x)); }


#define XB_TMO      128
#define XB_XCNT(j)  (256  + 64 * (j))
#define XB_XSUB(j)  (1280 + 64 * (j))
#define XB_XGEN(j)  (2304 + 64 * (j))
#define XB_TOP      3328
#define XB_TOPGEN   3392
#define XCD_BAR_WORDS 3456
#define XB_SPIN_CAP (1u << 22)
static_assert(XCD_BAR_WORDS * 4 <= BAR_BYTES, "barrier words");
__device__ __forceinline__ unsigned xb_ld(unsigned* p)              { return __hip_atomic_load(p, __ATOMIC_RELAXED, __HIP_MEMORY_SCOPE_AGENT); }
__device__ __forceinline__ unsigned xb_add(unsigned* p, unsigned v) { return __hip_atomic_fetch_add(p, v, __ATOMIC_RELAXED, __HIP_MEMORY_SCOPE_AGENT); }
__device__ __forceinline__ unsigned xb_xcc_id() { return (unsigned)__builtin_amdgcn_s_getreg((3 << 11) | 20) & 0xFu; }
#define XB_SPIN(cond, bar) do { unsigned _sp = 0; while (cond) { __builtin_amdgcn_s_sleep(1); \
    if ((++_sp & 255u) == 0u) { if (xb_ld(&(bar)[XB_TMO])) break; if (_sp > XB_SPIN_CAP) { atomicAdd(&(bar)[XB_TMO], 1u); break; } } } } while (0)
struct XcdBarrier { unsigned* bar; unsigned x; volatile LAS unsigned* st; };
__device__ __forceinline__ XcdBarrier xcd_barrier_post(unsigned* bar, volatile LAS unsigned* st) {
    XcdBarrier b; b.bar = bar; b.x = xb_xcc_id(); b.st = st;
    if (threadIdx.x == 0) (void)xb_add(&bar[XB_XCNT(b.x)], 1u);
    return b;
}
__device__ __forceinline__ void xcd_barrier_complete(unsigned* bar, unsigned x, unsigned& nloc, unsigned& nx) {
    const unsigned G = gridDim.x * gridDim.y * gridDim.z;
    unsigned sum, cnt, mine, sp = 0u;
    for (;;) {
        sum = 0u; cnt = 0u; mine = 0u;
#pragma unroll
        for (unsigned j = 0; j < 16; ++j) { const unsigned c = xb_ld(&bar[XB_XCNT(j)]); sum += c; cnt += (c > 0u) ? 1u : 0u; mine = (j == x) ? c : mine; }
        if (sum == G) break;
        __builtin_amdgcn_s_sleep(1);
        if ((++sp & 255u) == 0u) { if (xb_ld(&bar[XB_TMO])) break; if (sp > XB_SPIN_CAP) { atomicAdd(&bar[XB_TMO], 1u); break; } }
    }
    nloc = mine > 0u ? mine : 1u; nx = cnt > 0u ? cnt : 1u;
}
__device__ __forceinline__ void xcd_barrier(const XcdBarrier& b) {
    asm volatile("s_waitcnt vmcnt(0)" ::: "memory");
    __syncthreads();
    if (threadIdx.x == 0) {
        unsigned* bar = b.bar;
        __builtin_amdgcn_s_waitcnt(0);
        unsigned nloc = b.st[0], nx = b.st[1];
        if (nloc == 0u) { xcd_barrier_complete(bar, b.x, nloc, nx); b.st[0] = nloc; b.st[1] = nx; }
        const unsigned old = xb_add(&bar[XB_XSUB(b.x)], 1u);
        const unsigned gen = old / nloc;
        if (old + 1u == (gen + 1u) * nloc) {
            __builtin_amdgcn_fence(__ATOMIC_RELEASE, "agent");
            asm volatile("s_waitcnt vmcnt(0)" ::: "memory");
            const unsigned og = xb_add(&bar[XB_TOP], 1u);
            const unsigned tg = og / nx;
            if (og + 1u == (tg + 1u) * nx) xb_add(&bar[XB_TOPGEN], 1u);
            else XB_SPIN(xb_ld(&bar[XB_TOPGEN]) == tg, bar);
            __builtin_amdgcn_fence(__ATOMIC_ACQUIRE, "agent");
            xb_add(&bar[XB_XGEN(b.x)], 1u);
            asm volatile("s_waitcnt vmcnt(0)" ::: "memory");
        } else {
            XB_SPIN(xb_ld(&bar[XB_XGEN(b.x)]) == gen, bar);
            __builtin_amdgcn_fence(__ATOMIC_ACQUIRE, "agent");
            asm volatile("s_waitcnt vmcnt(0)" ::: "memory");
        }
    }
    __syncthreads();
}

constexpr int BM = 256, BK = 64, HALF = 128, HTB = HALF * BK * 2, NXCD = 8, WGM = 8;

__device__ __forceinline__ int lds_byte(int r, int c) { const int st = (r >> 4) * 2 + (c >> 5), rr = r & 15, cc = c & 31, ob = rr * 64 + cc * 2; return st * 1024 + (ob ^ (((ob >> 9) & 1) << 5)); }
__device__ __forceinline__ void stage_rc(int b, int& R, int& C) { const int st = b / 1024, sb = b % 1024, swz = sb ^ (((sb >> 9) & 1) << 5); R = (st >> 1) * 16 + swz / 64; C = (st & 1) * 32 + (swz % 64) / 2; }
__device__ __forceinline__ int perm32(int rho) { const int n = rho >> 4, i = rho & 15; return 8 * (i >> 2) + 4 * n + (i & 3); }

struct GemmDesc {
    const bf16_t* A; const bf16_t* Bt; int lda, ldb, K;
    int nM, nN, nZ, zdiv;
    long sA0, sA1, sB0, sB1;
    int rz0, cz1;
    int shift;
    int kind;
    void* out; void* out2; int ldc; const float* bias; float scale; int act; float alpha;
};
struct Unit { const char* a; const char* b; int row0, col0; };

__device__ __forceinline__ bool next_unit(const GemmDesc& d, int i, int G, int c, Unit& u) {
    const int per = d.nM * d.nN; const long L = (long)i * G + c;
    if (L >= (long)per * d.nZ) return false;
    const int z = (int)(L / per); int w = (int)(L % per); int pm, pn;
    if (d.nZ == 1) {
        const int nwg = per; const int q = nwg / NXCD, r = nwg % NXCD, xcd = w % NXCD, off = w / NXCD;
        w = (xcd < r ? xcd * (q + 1) : r * (q + 1) + (xcd - r) * q) + off;
        const int nig = WGM * d.nN, gid = w / nig, fm = gid * WGM, gsz = (d.nM - fm) < WGM ? (d.nM - fm) : WGM;
        pm = fm + ((w % nig) % gsz); pn = (w % nig) / gsz;
    } else { pm = w % d.nM; pn = w / d.nM; }
    const int z0 = z / d.zdiv, z1 = z % d.zdiv;
    u.a = (const char*)(d.A + (long)z0 * d.sA0 + (long)z1 * d.sA1 + (long)pm * BM * d.lda);
    u.b = (const char*)(d.Bt + (long)z0 * d.sB0 + (long)z1 * d.sB1 + (long)pn * BM * d.ldb);
    u.row0 = z0 * d.rz0 + pm * BM; u.col0 = z1 * d.cz1 + pn * BM;
    return true;
}

__device__ __forceinline__ void gemm_epilogue(const f32x4 (&acc)[2][2][4][2], const GemmDesc& d, const Unit& u, int wr, int wc, int fr, int fq) {
    const int row0 = u.row0 + wr * 64 + fr, col0 = u.col0 + wc * 32 + 8 * fq;
    f32x4 bv[2][2];
#pragma unroll
    for (int bj = 0; bj < 2; ++bj)
#pragma unroll
        for (int n = 0; n < 2; ++n) bv[bj][n] = d.bias ? *(const f32x4*)(d.bias + col0 + bj * HALF + 4 * n) : (f32x4){0.f, 0.f, 0.f, 0.f};
    const float sc = d.scale;
    if (d.kind == 2 && u.col0 >= 768) {
        bf16_t* O = (bf16_t*)d.out2; const int ucol = ((u.col0 - 768) >> 1) + wc * 32 + 8 * fq;
#pragma unroll
        for (int ai = 0; ai < 2; ++ai)
#pragma unroll
            for (int m = 0; m < 4; ++m) {
                f32x4 v0 = acc[ai][0][m][0], v1 = acc[ai][0][m][1]; const f32x4 g0 = acc[ai][1][m][0], g1 = acc[ai][1][m][1];
#pragma unroll
                for (int j = 0; j < 4; ++j) { v0[j] *= sigmoidf_(g0[j]); v1[j] *= sigmoidf_(g1[j]); }
                u32x4 w; w.x = cvt_pk_bf16(v0[0], v0[1]); w.y = cvt_pk_bf16(v0[2], v0[3]); w.z = cvt_pk_bf16(v1[0], v1[1]); w.w = cvt_pk_bf16(v1[2], v1[3]);
                *(u32x4*)(O + (size_t)(row0 + ai * HALF + m * 16) * 512 + ucol) = w;
            }
        return;
    }
    if (d.kind != 1) {
        bf16_t* O = (bf16_t*)d.out;
#pragma unroll
        for (int ai = 0; ai < 2; ++ai)
#pragma unroll
            for (int m = 0; m < 4; ++m) {
                bf16_t* rowp = O + (size_t)(row0 + ai * HALF + m * 16) * d.ldc + col0;
#pragma unroll
                for (int bj = 0; bj < 2; ++bj) {
                    f32x4 v0 = acc[ai][bj][m][0] * sc + bv[bj][0], v1 = acc[ai][bj][m][1] * sc + bv[bj][1];
                    if (d.act == 1) {
#pragma unroll
                        for (int j = 0; j < 4; ++j) { float a = fmaxf(v0[j], 0.f), b = fmaxf(v1[j], 0.f); v0[j] = a * a; v1[j] = b * b; }
                    }
                    if (d.kind == 3) {
                        const u32x4 ov = *(const u32x4*)(rowp + bj * HALF); const float al = d.alpha;
                        v0[0] += al * bflo(ov.x); v0[1] += al * bfhi(ov.x); v0[2] += al * bflo(ov.y); v0[3] += al * bfhi(ov.y);
                        v1[0] += al * bflo(ov.z); v1[1] += al * bfhi(ov.z); v1[2] += al * bflo(ov.w); v1[3] += al * bfhi(ov.w);
                    }
                    u32x4 w; w.x = cvt_pk_bf16(v0[0], v0[1]); w.y = cvt_pk_bf16(v0[2], v0[3]); w.z = cvt_pk_bf16(v1[0], v1[1]); w.w = cvt_pk_bf16(v1[2], v1[3]);
                    *(u32x4*)(rowp + bj * HALF) = w;
                }
            }
    } else {
        float* C = (float*)d.out; const float al = d.alpha;
#pragma unroll
        for (int ai = 0; ai < 2; ++ai)
#pragma unroll
            for (int m = 0; m < 4; ++m) {
                float* rowp = C + (size_t)(row0 + ai * HALF + m * 16) * d.ldc + col0;
#pragma unroll
                for (int bj = 0; bj < 2; ++bj) {
                    f32x4 v0 = acc[ai][bj][m][0] * sc + bv[bj][0], v1 = acc[ai][bj][m][1] * sc + bv[bj][1];
                    if (al != 0.f) { const f32x4 o0 = *(const f32x4*)(rowp + bj * HALF), o1 = *(const f32x4*)(rowp + bj * HALF + 4); v0 += o0 * al; v1 += o1 * al; }
                    *(f32x4*)(rowp + bj * HALF) = v0; *(f32x4*)(rowp + bj * HALF + 4) = v1;
                }
            }
    }
}

__device__ __forceinline__ void gemm_phase(LAS unsigned char* lds, const GemmDesc& d) {
    const int tid = otid(), wid = __builtin_amdgcn_readfirstlane(tid >> 6), lane = tid & 63, wr = wid >> 2, wc = wid & 3, fr = lane & 15, fq = lane >> 4;
    const int G = ogrid(); int cblk = obid() - d.shift; if (cblk < 0) cblk += G;
    const int K = d.K, nt = K / BK;
    unsigned voffA[2], voffB[2];
#pragma unroll
    for (int i = 0; i < 2; ++i) { int R, C; stage_rc(tid * 16 + i * 8192, R, C); const int Rb = (R & ~31) + perm32(R & 31);
        voffA[i] = (unsigned)(R * d.lda + C) * 2u; voffB[i] = (unsigned)(Rb * d.ldb + C) * 2u; }
    const size_t kstep = (size_t)(BK * 2);
    const size_t hstepA = (size_t)HALF * d.lda * 2, hstepB = (size_t)HALF * d.ldb * 2;
    const unsigned ldsw = (unsigned)wid * 1024u;
    const int aoff = lds_byte(wr * 64 + fr, fq * 8), boff = lds_byte(wc * 32 + fr, fq * 8);
#define PG8_SA(b, h) (((b) * 2 + (h)) * HTB)
#define PG8_SB(b, h) ((4 + (b) * 2 + (h)) * HTB)
#define PG8_STAGE(bufoff, gbase, voff) do { _Pragma("unroll") for (int _i = 0; _i < 2; ++_i) \
        __builtin_amdgcn_global_load_lds((const unsigned*)((const char*)(gbase) + (voff)[_i]), (LAS unsigned*)(lds + (bufoff) + ldsw + _i * 8192), 16, 0, 0); } while (0)
#define PG8_LDA(dst, b, h) do { _Pragma("unroll") for (int m = 0; m < 4; ++m) _Pragma("unroll") for (int k = 0; k < 2; ++k) dst[m][k] = *(const LAS bf16x8*)(lds + PG8_SA(b, h) + aoff + m * 2048 + k * 1024); } while (0)
#define PG8_LDB(dst, b, h) do { _Pragma("unroll") for (int n = 0; n < 2; ++n) _Pragma("unroll") for (int k = 0; k < 2; ++k) dst[n][k] = *(const LAS bf16x8*)(lds + PG8_SB(b, h) + boff + n * 2048 + k * 1024); } while (0)
#define PG8_MMA(ai, bj, At, Bt) do { __builtin_amdgcn_s_setprio(1); _Pragma("unroll") for (int m = 0; m < 4; ++m) _Pragma("unroll") for (int n = 0; n < 2; ++n) _Pragma("unroll") for (int k = 0; k < 2; ++k) \
        acc[ai][bj][m][n] = __builtin_amdgcn_mfma_f32_16x16x32_bf16(Bt[n][k], At[m][k], acc[ai][bj][m][n], 0, 0, 0); __builtin_amdgcn_s_setprio(0); } while (0)
#define PG8_WAIT_V(n) asm volatile("s_waitcnt vmcnt(" #n ")" ::: "memory")
#define PG8_WAIT_L(n) asm volatile("s_waitcnt lgkmcnt(" #n ")" ::: "memory")
#define PG8_BAR __builtin_amdgcn_s_barrier()
#define PG8_SCHED __builtin_amdgcn_sched_barrier(0)
    Unit cur, nxt; int ui = 0;
    if (!next_unit(d, 0, G, cblk, cur)) return;
    f32x4 acc[2][2][4][2];
#pragma unroll
    for (int a = 0; a < 2; ++a)
#pragma unroll
        for (int b = 0; b < 2; ++b)
#pragma unroll
            for (int m = 0; m < 4; ++m)
#pragma unroll
                for (int n = 0; n < 2; ++n) acc[a][b][m][n] = (f32x4){0.f, 0.f, 0.f, 0.f};
    bf16x8 At[4][2], B0[2][2], B1[2][2];
    const char* cA = cur.a; const char* cB = cur.b;
    PG8_STAGE(PG8_SB(0, 0), cB, voffB); PG8_STAGE(PG8_SA(0, 0), cA, voffA); PG8_STAGE(PG8_SB(0, 1), cB + hstepB, voffB); PG8_STAGE(PG8_SA(0, 1), cA + hstepA, voffA);
    if (wr == 1) PG8_BAR;
    PG8_WAIT_V(4); PG8_BAR;
    PG8_STAGE(PG8_SB(1, 0), cB + kstep, voffB); PG8_STAGE(PG8_SA(1, 0), cA + kstep, voffA); PG8_STAGE(PG8_SB(1, 1), cB + hstepB + kstep, voffB);
    PG8_WAIT_V(6); PG8_BAR;
    for (;;) {
        const bool has_next = next_unit(d, ui + 1, G, cblk, nxt);
        const char* nA = has_next ? nxt.a : cA; const char* nB = has_next ? nxt.b : cB;
        for (int t = 0; t < nt; t += 2) {
            const bool last = (t == nt - 2);
            const char* a1 = cA + (size_t)(t + 1) * kstep;
            const char* a2 = last ? nA : cA + (size_t)(t + 2) * kstep; const char* b2 = last ? nB : cB + (size_t)(t + 2) * kstep;
            const char* a3 = a2 + kstep; const char* b3 = b2 + kstep;
            PG8_LDB(B0, 0, 0); PG8_SCHED; PG8_LDA(At, 0, 0); PG8_STAGE(PG8_SA(1, 1), a1 + hstepA, voffA);
            PG8_WAIT_L(8); PG8_BAR; PG8_WAIT_L(0); PG8_MMA(0, 0, At, B0); PG8_BAR; PG8_SCHED;
            PG8_LDB(B1, 0, 1); PG8_STAGE(PG8_SB(0, 0), b2, voffB);
            PG8_BAR; PG8_WAIT_L(0); PG8_MMA(0, 1, At, B1); PG8_BAR;
            PG8_LDA(At, 0, 1); PG8_STAGE(PG8_SA(0, 0), a2, voffA);
            PG8_BAR; PG8_WAIT_L(0); PG8_MMA(1, 0, At, B0); PG8_BAR; PG8_SCHED;
            PG8_STAGE(PG8_SB(0, 1), b2 + hstepB, voffB);
            PG8_WAIT_V(6); PG8_BAR; PG8_MMA(1, 1, At, B1); PG8_BAR;
            PG8_LDB(B0, 1, 0); PG8_SCHED; PG8_LDA(At, 1, 0); PG8_STAGE(PG8_SA(0, 1), a2 + hstepA, voffA);
            PG8_WAIT_L(8); PG8_BAR; PG8_WAIT_L(0); PG8_MMA(0, 0, At, B0); PG8_BAR; PG8_SCHED;
            PG8_LDB(B1, 1, 1); PG8_STAGE(PG8_SB(1, 0), b3, voffB);
            PG8_BAR; PG8_WAIT_L(0); PG8_MMA(0, 1, At, B1); PG8_BAR;
            PG8_LDA(At, 1, 1); PG8_STAGE(PG8_SA(1, 0), a3, voffA);
            PG8_BAR; PG8_WAIT_L(0); PG8_MMA(1, 0, At, B0); PG8_BAR; PG8_SCHED;
            PG8_STAGE(PG8_SB(1, 1), b3 + hstepB, voffB);
            PG8_WAIT_V(6); PG8_BAR; PG8_MMA(1, 1, At, B1); PG8_BAR;
        }
        gemm_epilogue(acc, d, cur, wr, wc, fr, fq);
        if (!has_next) break;
#pragma unroll
        for (int a = 0; a < 2; ++a)
#pragma unroll
            for (int b = 0; b < 2; ++b)
#pragma unroll
                for (int m = 0; m < 4; ++m)
#pragma unroll
                    for (int n = 0; n < 2; ++n) acc[a][b][m][n] = (f32x4){0.f, 0.f, 0.f, 0.f};
        cur = nxt; cA = nA; cB = nB; ++ui;
    }
    PG8_WAIT_V(0);
    if (wr == 0) PG8_BAR;
    PG8_BAR;
#undef PG8_SA
#undef PG8_SB
#undef PG8_STAGE
#undef PG8_LDA
#undef PG8_LDB
#undef PG8_MMA
#undef PG8_WAIT_V
#undef PG8_WAIT_L
#undef PG8_BAR
#undef PG8_SCHED
}

namespace att {
constexpr int D = 64, NW = 8, QBLK = 32, KVBLK = 64;
constexpr float SCALE = 0.125f, THR = 8.f;
constexpr int SHM_V = KVBLK * D * 2, SHM_K = KVBLK * D * 2;
constexpr int LDQ = 512, LDK = 128, LDV = 768, LDY = DM;
#define KSWZ(row, colB) ((row) * 128 + ((colB) ^ ((((row) >> 1) & 7) << 4)))
#define SBAR() __builtin_amdgcn_sched_barrier(0)
__device__ __forceinline__ int crow(int r, int hi) { return (r & 3) + 8 * (r >> 2) + 4 * hi; }

__device__ __forceinline__ void partialSM(f32x16& p0, f32x16& p1, float& m_reg, float& mn, float& alpha) {
    constexpr float C = SCALE * 1.4426950408889634f;
    float pmax = p0[0];
#pragma unroll
    for (int r = 1; r < 16; ++r) pmax = fmaxf(pmax, p0[r]);
#pragma unroll
    for (int r = 0; r < 16; ++r) pmax = fmaxf(pmax, p1[r]);
    { auto rr = __builtin_amdgcn_permlane32_swap(__float_as_uint(pmax), __float_as_uint(pmax), false, false);
      pmax = fmaxf(__uint_as_float(rr[0]), __uint_as_float(rr[1])); }
    if (__builtin_expect(__all(pmax - m_reg <= THR / SCALE), 1)) { mn = m_reg; alpha = 1.f; }
    else { mn = fmaxf(m_reg, pmax); alpha = __builtin_amdgcn_exp2f((m_reg - mn) * C); m_reg = mn; }
    const float mnC = -mn * C;
#pragma unroll
    for (int r = 0; r < 16; ++r) p0[r] = fmaf(p0[r], C, mnC);
#pragma unroll
    for (int r = 0; r < 16; ++r) p1[r] = fmaf(p1[r], C, mnC);
#pragma unroll
    for (int r = 0; r < 16; ++r) p0[r] = __builtin_amdgcn_exp2f(p0[r]);
}
__device__ __forceinline__ void finishSM(f32x16& p0, f32x16& p1, float alpha, float& l_reg, bf16x8& pa0, bf16x8& pa1, bf16x8& pa2, bf16x8& pa3) {
#pragma unroll
    for (int r = 0; r < 16; ++r) p1[r] = __builtin_amdgcn_exp2f(p1[r]);
    float ps = 0;
#pragma unroll
    for (int r = 0; r < 16; ++r) ps += p0[r];
#pragma unroll
    for (int r = 0; r < 16; ++r) ps += p1[r];
    { auto rr = __builtin_amdgcn_permlane32_swap(__float_as_uint(ps), __float_as_uint(ps), false, false);
      ps = __uint_as_float(rr[0]) + __uint_as_float(rr[1]); }
    l_reg = l_reg * alpha + ps;
#define PK4(P, BASE, OUT) do { unsigned a0 = cvt_pk_bf16(P[BASE + 0], P[BASE + 1]), a1 = cvt_pk_bf16(P[BASE + 2], P[BASE + 3]);   \
    unsigned b0 = cvt_pk_bf16(P[BASE + 4], P[BASE + 5]), b1 = cvt_pk_bf16(P[BASE + 6], P[BASE + 7]);                              \
    auto r0 = __builtin_amdgcn_permlane32_swap(a0, b0, false, false); auto r1 = __builtin_amdgcn_permlane32_swap(a1, b1, false, false); \
    u32x4 w = {r0[0], r1[0], r0[1], r1[1]}; OUT = *reinterpret_cast<bf16x8*>(&w); } while (0)
    PK4(p0, 0, pa0); PK4(p0, 8, pa1); PK4(p1, 0, pa2); PK4(p1, 8, pa3);
#undef PK4
}
__device__ __forceinline__ void qkt(f32x16& p0, f32x16& p1, const char* Ks, const bf16x8* qr, int r32, int hi) {
    p0 = f32x16{}; p1 = f32x16{};
#pragma unroll
    for (int d0 = 0; d0 < 4; ++d0) { const int cb = (d0 * 16 + hi * 8) * 2;
        bf16x8 b0 = *reinterpret_cast<const bf16x8*>(Ks + KSWZ(r32, cb));
        bf16x8 b1 = *reinterpret_cast<const bf16x8*>(Ks + KSWZ(32 + r32, cb));
        p0 = __builtin_amdgcn_mfma_f32_32x32x16_bf16(b0, qr[d0], p0, 0, 0, 0);
        p1 = __builtin_amdgcn_mfma_f32_32x32x16_bf16(b1, qr[d0], p1, 0, 0, 0); }
}
__device__ __forceinline__ int v_st(int k, int c) { const int kk = (k & ~0xC) | ((k & 4) << 1) | ((k & 8) >> 1); return ((kk >> 3) * 2 + (c >> 5)) * 512 + ((kk & 7) * 32 + (c & 31)) * 2; }
__device__ __forceinline__ int v_rd_base(int lane) { return ((lane & 3) << 3) | (((lane >> 2) & 3) << 6) | (((lane >> 4) & 1) << 5) | (((lane >> 5) & 1) << 8); }
constexpr int v_rd_off(int d0, int ks, int half) { return d0 * 512 + ks * 2048 + half * 1024; }
template <int OFF> __device__ __forceinline__ s16x4 tr_read(int vb) {
    s16x4 r; asm volatile("ds_read_b64_tr_b16 %0, %1 offset:%2" : "=&v"(r) : "v"(vb), "i"(OFF) : "memory"); return r;
}
template <int D0> __device__ __forceinline__ void pv_one(f32x16& od, int vb, bf16x8 pa0, bf16x8 pa1, bf16x8 pa2, bf16x8 pa3) {
    const s16x4 l0 = tr_read<v_rd_off(D0, 0, 0)>(vb), h0 = tr_read<v_rd_off(D0, 0, 1)>(vb), l1 = tr_read<v_rd_off(D0, 1, 0)>(vb), h1 = tr_read<v_rd_off(D0, 1, 1)>(vb);
    const s16x4 l2 = tr_read<v_rd_off(D0, 2, 0)>(vb), h2 = tr_read<v_rd_off(D0, 2, 1)>(vb), l3 = tr_read<v_rd_off(D0, 3, 0)>(vb), h3 = tr_read<v_rd_off(D0, 3, 1)>(vb);
    asm volatile("s_waitcnt lgkmcnt(0)" ::: "memory"); SBAR();
#define PK(L, H) (bf16x8){L[0], L[1], L[2], L[3], H[0], H[1], H[2], H[3]}
    od = __builtin_amdgcn_mfma_f32_32x32x16_bf16(pa0, PK(l0, h0), od, 0, 0, 0);
    od = __builtin_amdgcn_mfma_f32_32x32x16_bf16(pa1, PK(l1, h1), od, 0, 0, 0);
    od = __builtin_amdgcn_mfma_f32_32x32x16_bf16(pa2, PK(l2, h2), od, 0, 0, 0);
    od = __builtin_amdgcn_mfma_f32_32x32x16_bf16(pa3, PK(l3, h3), od, 0, 0, 0);
#undef PK
}
__device__ __forceinline__ void pv_d0(f32x16* o, int vb, bf16x8 pa0, bf16x8 pa1, bf16x8 pa2, bf16x8 pa3) {
    pv_one<0>(o[0], vb, pa0, pa1, pa2, pa3); pv_one<1>(o[1], vb, pa0, pa1, pa2, pa3);
}

__device__ __forceinline__ void attn_body(const bf16_t* __restrict__ Qb, const bf16_t* __restrict__ Kh, const bf16_t* __restrict__ Vh,
                                          bf16_t* __restrict__ Yb, const float* __restrict__ gain, int seq, char* lds) {
    const int tid = otid(), wid = tid >> 6, lane = tid & 63, r32 = lane & 31, hi = lane >> 5;
    char* V_lds = lds; char* K_lds = lds + 2 * SHM_V;
    float* ws = (float*)(lds + 2 * SHM_V + 2 * SHM_K) + wid * 64; float* li_l = ws; float* al_l = ws + 32;
    float m_reg = -1e30f, l_reg = 0; f32x16 o[2] = {}; bf16x8 qr[4];
    const bf16_t* Qw = Qb + (long)(wid * QBLK + r32) * LDQ + hi * 8;
#pragma unroll
    for (int d0 = 0; d0 < 4; ++d0) qr[d0] = *reinterpret_cast<const bf16x8*>(Qw + d0 * 16);
    const int sr = tid >> 3, sc = (tid & 7) * 8, vst0 = v_st(sr, sc), kst0 = KSWZ(sr, sc * 2);
    const int vb0 = (int)(uintptr_t)V_lds + v_rd_base(lane);
    bf16x8 vsE, ksE, vsO, ksO;
#define SLOADE(k0) do { vsE = *reinterpret_cast<const bf16x8*>(&Vh[(long)((k0) + sr) * LDV + sc]); ksE = *reinterpret_cast<const bf16x8*>(&Kh[(long)((k0) + sr) * LDK + sc]); } while (0)
#define SLOADO(k0) do { vsO = *reinterpret_cast<const bf16x8*>(&Vh[(long)((k0) + sr) * LDV + sc]); ksO = *reinterpret_cast<const bf16x8*>(&Kh[(long)((k0) + sr) * LDK + sc]); } while (0)
#define SWRITEE(b) do { *(bf16x8*)(V_lds + (b) * SHM_V + vst0) = vsE; *(bf16x8*)(K_lds + (b) * SHM_K + kst0) = ksE; } while (0)
#define SWRITEO(b) do { *(bf16x8*)(V_lds + (b) * SHM_V + vst0) = vsO; *(bf16x8*)(K_lds + (b) * SHM_K + kst0) = ksO; } while (0)
#define SWAIT() asm volatile("s_waitcnt vmcnt(2)" ::: "memory")
#define RESC(a) do { if (__any((a) < 1.f)) { if (hi == 0) al_l[r32] = (a); asm volatile("s_waitcnt lgkmcnt(0)" ::: "memory"); \
    _Pragma("unroll") for (int dd = 0; dd < 2; ++dd) _Pragma("unroll") for (int r = 0; r < 16; ++r) o[dd][r] *= al_l[crow(r, hi)]; } } while (0)
    f32x16 pA0, pA1, pB0, pB1; float mnA, mnB, alA, alB; bf16x8 pa0, pa1, pa2, pa3; const int NTL = seq / KVBLK;
    SLOADE(0); asm volatile("s_waitcnt vmcnt(0)" ::: "memory"); SWRITEE(0); __syncthreads();
    qkt(pA0, pA1, K_lds, qr, r32, hi); partialSM(pA0, pA1, m_reg, mnA, alA);
    SLOADO(KVBLK); if (2 < NTL) SLOADE(2 * KVBLK);
    SWAIT(); SWRITEO(1); __syncthreads();
    for (int j = 1; j + 1 < NTL; j += 2) {
        SBAR(); qkt(pB0, pB1, K_lds + SHM_K, qr, r32, hi);
        finishSM(pA0, pA1, alA, l_reg, pa0, pa1, pa2, pa3); SBAR();
        SLOADO((j + 2) * KVBLK); SBAR();
        pv_d0(o, vb0, pa0, pa1, pa2, pa3); partialSM(pB0, pB1, m_reg, mnB, alB);
        __syncthreads(); SWAIT(); SWRITEE(0);
        RESC(alB); __syncthreads();
        SBAR(); qkt(pA0, pA1, K_lds, qr, r32, hi);
        finishSM(pB0, pB1, alB, l_reg, pa0, pa1, pa2, pa3); SBAR();
        if (j + 3 < NTL) SLOADE((j + 3) * KVBLK); SBAR();
        pv_d0(o, vb0 + SHM_V, pa0, pa1, pa2, pa3); partialSM(pA0, pA1, m_reg, mnA, alA);
        __syncthreads(); SWAIT(); SWRITEO(1);
        RESC(alA); __syncthreads();
    }
    SBAR(); qkt(pB0, pB1, K_lds + SHM_K, qr, r32, hi);
    finishSM(pA0, pA1, alA, l_reg, pa0, pa1, pa2, pa3); SBAR();
    pv_d0(o, vb0, pa0, pa1, pa2, pa3); partialSM(pB0, pB1, m_reg, mnB, alB);
    __syncthreads(); RESC(alB);
    finishSM(pB0, pB1, alB, l_reg, pa0, pa1, pa2, pa3); SBAR();
    pv_d0(o, vb0 + SHM_V, pa0, pa1, pa2, pa3);
    if (hi == 0) li_l[r32] = l_reg; asm volatile("s_waitcnt lgkmcnt(0)" ::: "memory");
    const float g0 = gain[r32], g1 = gain[32 + r32];
    bf16_t* Yw = Yb + (long)(wid * QBLK) * LDY;
#pragma unroll
    for (int r = 0; r < 16; ++r) {
        const int orow = crow(r, hi);
        const float rl = __builtin_amdgcn_rcpf(li_l[orow]);
        const float a = o[0][r] * rl, b = o[1][r] * rl;
        float ss = a * a + b * b;
        ss = sum16(ss); ss += __shfl_xor(ss, 16);
        const float rs = rsqrtf(ss * (1.f / 64.f) + LN_EPS);
        const unsigned wa = cvt_pk_bf16(a * rs * g0, b * rs * g1);
        Yw[(long)orow * LDY + r32] = (bf16_t)(wa & 0xffffu);
        Yw[(long)orow * LDY + 32 + r32] = (bf16_t)(wa >> 16);
    }
    __syncthreads();
#undef SLOADE
#undef SLOADO
#undef SWRITEE
#undef SWRITEO
#undef SWAIT
#undef RESC
}
}

__device__ __forceinline__ void ln_rows(const float* src, float* dstf, bf16_t* dstb, const float* __restrict__ g, const float* __restrict__ b) {
    const int tid = otid(), lane = tid & 63, wid = tid >> 6;
    const int nw = ogrid() * 8;
    f32x4 gv[4], bv[4];
#pragma unroll
    for (int j = 0; j < 4; ++j) { gv[j] = *(const f32x4*)(g + j * 256 + lane * 4); bv[j] = *(const f32x4*)(b + j * 256 + lane * 4); }
    for (int row0 = obid() * 8 + wid; row0 < MTOK; row0 += 2 * nw) {
        f32x4 v[2][4];
#pragma unroll
        for (int u = 0; u < 2; ++u) { const int row = row0 + u * nw; const float* sp = src + (size_t)(row < MTOK ? row : row0) * DM;
#pragma unroll
            for (int j = 0; j < 4; ++j) v[u][j] = *(const f32x4*)(sp + j * 256 + lane * 4); }
#pragma unroll
        for (int u = 0; u < 2; ++u) {
            const int row = row0 + u * nw; if (row >= MTOK) break;
            float s = 0.f;
#pragma unroll
            for (int j = 0; j < 4; ++j) s += v[u][j][0] + v[u][j][1] + v[u][j][2] + v[u][j][3];
            const float mean = wave_sum(s) * (1.f / DM);
            float q = 0.f;
#pragma unroll
            for (int j = 0; j < 4; ++j) { v[u][j] -= mean; q += v[u][j][0] * v[u][j][0] + v[u][j][1] * v[u][j][1] + v[u][j][2] * v[u][j][2] + v[u][j][3] * v[u][j][3]; }
            const float rstd = rsqrtf(wave_sum(q) * (1.f / DM) + LN_EPS);
#pragma unroll
            for (int j = 0; j < 4; ++j) {
                const f32x4 y = v[u][j] * rstd * gv[j] + bv[j];
                if (dstf) *(f32x4*)(dstf + (size_t)row * DM + j * 256 + lane * 4) = y;
                if (dstb) { u32x2 w; w.x = cvt_pk_bf16(y[0], y[1]); w.y = cvt_pk_bf16(y[2], y[3]); *(u32x2*)(dstb + (size_t)row * DM + j * 256 + lane * 4) = w; }
            }
        }
    }
}

__device__ __forceinline__ void ln_rows_bf16(const bf16_t* src, bf16_t* dstb, float* dstf, const float* __restrict__ g, const float* __restrict__ b) {
    const int tid = otid(), lane = tid & 63, wid = tid >> 6;
    const int nw = ogrid() * 8;
    f32x4 gv[4], bv[4];
#pragma unroll
    for (int j = 0; j < 4; ++j) { gv[j] = *(const f32x4*)(g + lane * 16 + j * 4); bv[j] = *(const f32x4*)(b + lane * 16 + j * 4); }
    for (int row0 = obid() * 8 + wid; row0 < MTOK; row0 += 2 * nw) {
        u32x4 raw[2][2];
#pragma unroll
        for (int u = 0; u < 2; ++u) { const int row = row0 + u * nw; const bf16_t* sp = src + (size_t)(row < MTOK ? row : row0) * DM + lane * 16;
            raw[u][0] = *(const u32x4*)sp; raw[u][1] = *(const u32x4*)(sp + 8); }
#pragma unroll
        for (int u = 0; u < 2; ++u) {
            const int row = row0 + u * nw; if (row >= MTOK) break;
            f32x4 v[4];
#pragma unroll
            for (int h = 0; h < 2; ++h) { const u32x4 r = raw[u][h];
                v[2 * h] = (f32x4){bflo(r.x), bfhi(r.x), bflo(r.y), bfhi(r.y)}; v[2 * h + 1] = (f32x4){bflo(r.z), bfhi(r.z), bflo(r.w), bfhi(r.w)}; }
            float s = 0.f;
#pragma unroll
            for (int j = 0; j < 4; ++j) s += v[j][0] + v[j][1] + v[j][2] + v[j][3];
            const float mean = wave_sum(s) * (1.f / DM);
            float q = 0.f;
#pragma unroll
            for (int j = 0; j < 4; ++j) { v[j] -= mean; q += v[j][0] * v[j][0] + v[j][1] * v[j][1] + v[j][2] * v[j][2] + v[j][3] * v[j][3]; }
            const float rstd = rsqrtf(wave_sum(q) * (1.f / DM) + LN_EPS);
#pragma unroll
            for (int j = 0; j < 4; ++j) v[j] = v[j] * rstd * gv[j] + bv[j];
            if (dstf) {
#pragma unroll
                for (int j = 0; j < 4; ++j) *(f32x4*)(dstf + (size_t)row * DM + lane * 16 + j * 4) = v[j];
            }
            if (dstb) {
                u32x4 w0, w1;
                w0.x = cvt_pk_bf16(v[0][0], v[0][1]); w0.y = cvt_pk_bf16(v[0][2], v[0][3]); w0.z = cvt_pk_bf16(v[1][0], v[1][1]); w0.w = cvt_pk_bf16(v[1][2], v[1][3]);
                w1.x = cvt_pk_bf16(v[2][0], v[2][1]); w1.y = cvt_pk_bf16(v[2][2], v[2][3]); w1.z = cvt_pk_bf16(v[3][0], v[3][1]); w1.w = cvt_pk_bf16(v[3][2], v[3][3]);
                *(u32x4*)(dstb + (size_t)row * DM + lane * 16) = w0; *(u32x4*)(dstb + (size_t)row * DM + lane * 16 + 8) = w1;
            }
        }
    }
}

constexpr int TLD = 257;
__device__ __forceinline__ void transpose_tile(const float* __restrict__ W, bf16_t* __restrict__ Wt, int K, int N, int tile, float* tl, bool glu) {
    const int tn = N >> 8; const int k0 = (tile / tn) * 64, n0 = (tile % tn) * 256; const int tid = otid();
    f32x4 v[8];
#pragma unroll
    for (int i = 0; i < 8; ++i) { const int q = tid + i * NTHR, kk = q >> 6, n4 = (q & 63) * 4;
        int ns = n0 + n4;
        if (glu && n0 >= 768) { const int blk = (n0 - 768) >> 8; ns = (n4 < 128) ? 768 + blk * 128 + n4 : 1280 + blk * 128 + (n4 - 128); }
        v[i] = *(const f32x4*)(W + (size_t)(k0 + kk) * N + ns); }
#pragma unroll
    for (int i = 0; i < 8; ++i) { const int q = tid + i * NTHR, kk = q >> 6, n4 = (q & 63) * 4; float* d = tl + kk * TLD + n4; d[0] = v[i][0]; d[1] = v[i][1]; d[2] = v[i][2]; d[3] = v[i][3]; }
    __syncthreads();
#pragma unroll
    for (int i = 0; i < 4; ++i) { const int q = tid + i * NTHR, nn = q >> 3, kc = (q & 7) * 8; float x[8];
#pragma unroll
        for (int j = 0; j < 8; ++j) x[j] = tl[(kc + j) * TLD + nn];
        u32x4 w; w.x = cvt_pk_bf16(x[0], x[1]); w.y = cvt_pk_bf16(x[2], x[3]); w.z = cvt_pk_bf16(x[4], x[5]); w.w = cvt_pk_bf16(x[6], x[7]);
        *(u32x4*)(Wt + (size_t)(n0 + nn) * K + k0 + kc) = w; }
    __syncthreads();
}

__device__ __forceinline__ void phase_prep(const Params& p, char* lds) {
    unsigned char* ws = p.ws; float* tl = (float*)lds;
    constexpr int T0 = 112, T1 = T0 + 64, T2 = T1 + 64, T3 = T2 + 128, T4 = T3 + 64, T5 = T4 + 256, T6 = T5 + 256;
    for (int t = blockIdx.x; t < T6; t += gridDim.x) {
        if (t < T0) transpose_tile(p.in[4], (bf16_t*)(ws + OFF_WIN), DM, INC, t, tl, true);
        else if (t < T1) transpose_tile(p.in[13], (bf16_t*)(ws + OFF_WOUT), DM, DM, t - T0, tl, false);
        else if (t < T2) transpose_tile(p.in[16], (bf16_t*)(ws + OFF_WMQ), DM, DM, t - T1, tl, false);
        else if (t < T3) transpose_tile(p.in[17], (bf16_t*)(ws + OFF_WMKV), DM, 2 * DM, t - T2, tl, false);
        else if (t < T4) transpose_tile(p.in[18], (bf16_t*)(ws + OFF_WMO), DM, DM, t - T3, tl, false);
        else if (t < T5) transpose_tile(p.in[21], (bf16_t*)(ws + OFF_WFF1), DM, DFF, t - T4, tl, false);
        else transpose_tile(p.in[23], (bf16_t*)(ws + OFF_WFF2), DFF, DM, t - T5, tl, false);
    }
    { float* sm = (float*)(ws + OFF_SMALL); const int gt = blockIdx.x * NTHR + threadIdx.x, gs = gridDim.x * NTHR;
#define CPY(idx, off, n) for (int i = gt; i < (n); i += gs) sm[(off) + i] = p.in[idx][i];
      CPY(5, SM_QG, 64) CPY(6, SM_KG, 64) CPY(7, SM_CONVW, 31 * 512) CPY(8, SM_CONVB, 512) CPY(9, SM_CLNG, 512) CPY(10, SM_CLNB, 512)
      CPY(11, SM_AOG, 512) CPY(12, SM_COG, 512) CPY(14, SM_LN1G, 1024) CPY(15, SM_LN1B, 1024) CPY(19, SM_LN2G, 1024) CPY(20, SM_LN2B, 1024)
      CPY(22, SM_BFF1, 4096) CPY(24, SM_BFF2, 1024) CPY(25, SM_LN3G, 1024) CPY(26, SM_LN3B, 1024)
#undef CPY
    }
    ln_rows(p.in[0], nullptr, (bf16_t*)(ws + OFF_B), p.in[2], p.in[3]);
    { const float* mem = p.in[1]; bf16_t* mb = (bf16_t*)(ws + OFF_MEMB);
      for (size_t i = ((size_t)blockIdx.x * NTHR + threadIdx.x) * 8; i < (size_t)MMEM * DM; i += (size_t)gridDim.x * NTHR * 8) {
          const f32x4 a = *(const f32x4*)(mem + i), b = *(const f32x4*)(mem + i + 4);
          u32x4 w; w.x = cvt_pk_bf16(a[0], a[1]); w.y = cvt_pk_bf16(a[2], a[3]); w.z = cvt_pk_bf16(b[0], b[1]); w.w = cvt_pk_bf16(b[2], b[3]);
          *(u32x4*)(mb + i) = w; } }
}

__device__ __forceinline__ void qk_chunk(const u32x4 raw, long g, const float* qg, const float* kg, bf16_t* qR, bf16_t* kR) {
    const int tok = (int)(g / 80), ch = (int)(g % 80), head = ch >> 3, part = ch & 7;
    float x[8]; x[0] = bflo(raw.x); x[1] = bfhi(raw.x); x[2] = bflo(raw.y); x[3] = bfhi(raw.y); x[4] = bflo(raw.z); x[5] = bfhi(raw.z); x[6] = bflo(raw.w); x[7] = bfhi(raw.w);
    float ss = 0.f;
#pragma unroll
    for (int j = 0; j < 8; ++j) ss += x[j] * x[j];
    ss = sum8(ss);
    const float rs = rsqrtf(ss * (1.f / 64.f) + LN_EPS);
    const float* gp = (head < 8 ? qg : kg) + part * 8;
    const f32x4 ga = *(const f32x4*)gp, gb = *(const f32x4*)(gp + 4);
    x[0] *= rs * ga[0]; x[1] *= rs * ga[1]; x[2] *= rs * ga[2]; x[3] *= rs * ga[3];
    x[4] *= rs * gb[0]; x[5] *= rs * gb[1]; x[6] *= rs * gb[2]; x[7] *= rs * gb[3];
    const int s = tok & (SEQ - 1);
    const float pos = (float)((part < 4) ? (s >> 6) : (s & 63));
    float y[8];
#pragma unroll
    for (int jj = 0; jj < 4; ++jj) {
        const int fi = (part & 3) * 4 + jj;
        const float inv = exp2f(-(float)fi * (13.287712379549449f / 16.f));
        const float ang = pos * inv;
        float sn, cs; __sincosf(ang, &sn, &cs);
        y[2 * jj] = x[2 * jj] * cs - x[2 * jj + 1] * sn;
        y[2 * jj + 1] = x[2 * jj] * sn + x[2 * jj + 1] * cs;
    }
    u32x4 w; w.x = cvt_pk_bf16(y[0], y[1]); w.y = cvt_pk_bf16(y[2], y[3]); w.z = cvt_pk_bf16(y[4], y[5]); w.w = cvt_pk_bf16(y[6], y[7]);
    if (head < 8) *(u32x4*)(qR + (size_t)tok * 512 + head * 64 + part * 8) = w;
    else *(u32x4*)(kR + (size_t)tok * 128 + (head - 8) * 64 + part * 8) = w;
}
__device__ __forceinline__ void phase_qk(const Params& p) {
    const bf16_t* proj = (const bf16_t*)(p.ws + OFF_T);
    bf16_t* qR = (bf16_t*)(p.ws + OFF_Q); bf16_t* kR = (bf16_t*)(p.ws + OFF_KR);
    const float* sm = (const float*)(p.ws + OFF_SMALL); const float* qg = sm + SM_QG; const float* kg = sm + SM_KG;
    const long total = (long)MTOK * 80, stride = (long)ogrid() * NTHR;
    for (long g0 = (long)obid() * NTHR + otid(); g0 < total; g0 += 5 * stride) {
        u32x4 raw[5];
#pragma unroll
        for (int k = 0; k < 5; ++k) { const long g = g0 + k * stride; raw[k] = (u32x4){0u, 0u, 0u, 0u};
            if (g < total) { const int tok = (int)(g / 80), ch = (int)(g % 80), head = ch >> 3, part = ch & 7; const int col = (head < 8) ? head * 64 : 512 + (head - 8) * 64;
                raw[k] = *(const u32x4*)(proj + (size_t)tok * 768 + col + part * 8); } }
#pragma unroll
        for (int k = 0; k < 5; ++k) { const long g = g0 + k * stride; if (g < total) qk_chunk(raw[k], g, qg, kg, qR, kR); }
    }
}

constexpr int CT = 32, CROWS = CT + 30;
__device__ __forceinline__ void phase_conv(const Params& p, char* lds) {
    const bf16_t* Ug = (const bf16_t*)(p.ws + OFF_U);
    bf16_t* Y = (bf16_t*)(p.ws + OFF_Y);
    const float* sm = (const float*)(p.ws + OFF_SMALL);
    bf16_t* Ub = (bf16_t*)lds;
    float* Z = (float*)(lds + CROWS * 512 * 2);
    static_assert(CROWS * 512 * 2 + CT * 512 * 4 <= LDS_MAIN, "conv LDS");
    const int tid = otid(), c = tid, lane = tid & 63, wid = tid >> 6;
    float w[31];
#pragma unroll
    for (int j = 0; j < 31; ++j) w[j] = sm[SM_CONVW + j * 512 + c];
    const float cb = sm[SM_CONVB + c];
    const f32x4 lg0 = *(const f32x4*)(sm + SM_CLNG + lane * 8), lg1 = *(const f32x4*)(sm + SM_CLNG + lane * 8 + 4);
    const f32x4 lb0 = *(const f32x4*)(sm + SM_CLNB + lane * 8), lb1 = *(const f32x4*)(sm + SM_CLNB + lane * 8 + 4);
    const f32x4 og0 = *(const f32x4*)(sm + SM_COG + lane * 8), og1 = *(const f32x4*)(sm + SM_COG + lane * 8 + 4);
    for (int tile = obid(); tile < MTOK / CT; tile += ogrid()) {
        const int tok0 = tile * CT, bb = tok0 / SEQ, s0 = tok0 % SEQ;
        { u32x4 sv[8];
#pragma unroll
          for (int i = 0; i < 8; ++i) { const int q = tid + i * NTHR, r = q >> 6, c8 = (q & 63) * 8; const int s = s0 - 15 + r;
              sv[i] = (u32x4){0u, 0u, 0u, 0u};
              if (q < CROWS * 64 && s >= 0 && s < SEQ) sv[i] = *(const u32x4*)(Ug + (size_t)(bb * SEQ + s) * 512 + c8); }
#pragma unroll
          for (int i = 0; i < 8; ++i) { const int q = tid + i * NTHR, r = q >> 6, c8 = (q & 63) * 8;
              if (q < CROWS * 64) *(u32x4*)(Ub + r * 512 + c8) = sv[i]; } }
        __syncthreads();
        {
            float uw[CROWS];
#pragma unroll
            for (int r = 0; r < CROWS; ++r) uw[r] = bf2f(Ub[r * 512 + c]);
#pragma unroll
            for (int t = 0; t < CT; ++t) {
                float a = cb;
#pragma unroll
                for (int j = 0; j < 31; ++j) a = fmaf(uw[t + j], w[j], a);
                Z[t * 512 + c] = a;
            }
        }
        __syncthreads();
#pragma unroll
        for (int k = 0; k < 4; ++k) {
            const int t = wid * 4 + k;
            f32x4 x0 = *(const f32x4*)(Z + t * 512 + lane * 8), x1 = *(const f32x4*)(Z + t * 512 + lane * 8 + 4);
            float s1 = (x0[0] + x0[1]) + (x0[2] + x0[3]) + (x1[0] + x1[1]) + (x1[2] + x1[3]);
            float s2 = x0[0] * x0[0] + x0[1] * x0[1] + x0[2] * x0[2] + x0[3] * x0[3] + x1[0] * x1[0] + x1[1] * x1[1] + x1[2] * x1[2] + x1[3] * x1[3];
            s1 = wave_sum(s1); s2 = wave_sum(s2);
            const float mean = s1 * (1.f / 512.f); const float var = fmaxf(s2 * (1.f / 512.f) - mean * mean, 0.f); const float rstd = rsqrtf(var + LN_EPS);
            f32x4 y0 = (x0 - mean) * rstd * lg0 + lb0, y1 = (x1 - mean) * rstd * lg1 + lb1;
            float gs = 0.f;
#pragma unroll
            for (int j = 0; j < 4; ++j) { y0[j] *= sigmoidf_(y0[j]); y1[j] *= sigmoidf_(y1[j]); gs += y0[j] * y0[j] + y1[j] * y1[j]; }
            gs = sum8(gs);
            const float rs = rsqrtf(gs * (1.f / 64.f) + LN_EPS);
            y0 = y0 * rs * og0; y1 = y1 * rs * og1;
            u32x4 wv; wv.x = cvt_pk_bf16(y0[0], y0[1]); wv.y = cvt_pk_bf16(y0[2], y0[3]); wv.z = cvt_pk_bf16(y1[0], y1[1]); wv.w = cvt_pk_bf16(y1[2], y1[3]);
            *(u32x4*)(Y + (size_t)(tok0 + t) * DM + 512 + lane * 8) = wv;
        }
    }
    __syncthreads();
}

__device__ __forceinline__ void phase_attn(const Params& p, char* lds) {
    const bf16_t* proj = (const bf16_t*)(p.ws + OFF_T);
    const bf16_t* qR = (const bf16_t*)(p.ws + OFF_Q); const bf16_t* kR = (const bf16_t*)(p.ws + OFF_KR);
    bf16_t* Y = (bf16_t*)(p.ws + OFF_Y);
    for (int item = obid(); item < BATCH * 8 * (SEQ / 256); item += ogrid()) {
        const int qb = item & 7, h = (item >> 3) & 7, b = item >> 6, kvh = h >> 2;
        const size_t tok0 = (size_t)b * SEQ;
        att::attn_body(qR + (tok0 + qb * 256) * 512 + h * 64, kR + tok0 * 128 + kvh * 64, proj + tok0 * 768 + 640 + kvh * 64,
                       Y + (tok0 + qb * 256) * DM + h * 64, (const float*)(p.ws + OFF_SMALL) + SM_AOG + h * 64, SEQ, lds);
    }
}

__device__ __forceinline__ void phase_softmax(const Params& p) {
    const float* Sc = (const float*)(p.ws + OFF_T); bf16_t* P = (bf16_t*)(p.ws + OFF_Y);
    const int tid = otid(), lane = tid & 63, wid = tid >> 6; const int nw = ogrid() * 8;
    for (int row = obid() * 8 + wid; row < MTOK; row += nw) {
#pragma unroll
        for (int h = 0; h < 4; ++h) {
            const f32x4 v = *(const f32x4*)(Sc + (size_t)row * DM + h * 256 + lane * 4);
            const float mx = wave_max(fmaxf(fmaxf(v[0], v[1]), fmaxf(v[2], v[3])));
            const float e0 = __expf(v[0] - mx), e1 = __expf(v[1] - mx), e2 = __expf(v[2] - mx), e3 = __expf(v[3] - mx);
            const float inv = 1.f / wave_sum(e0 + e1 + e2 + e3);
            u32x2 w; w.x = cvt_pk_bf16(e0 * inv, e1 * inv); w.y = cvt_pk_bf16(e2 * inv, e3 * inv);
            *(u32x2*)(P + (size_t)row * DM + h * 256 + lane * 4) = w;
        }
    }
}

__device__ __forceinline__ GemmDesc plain_gemm(const bf16_t* A, int lda, const bf16_t* Bt, int ldb, int M, int N, int K, int shift,
                                               int kind, void* out, int ldc, const float* bias, float scale, int act, float alpha) {
    GemmDesc d; d.A = A; d.Bt = Bt; d.lda = lda; d.ldb = ldb; d.K = K; d.nM = M / BM; d.nN = N / BM; d.nZ = 1; d.zdiv = 1;
    d.sA0 = d.sA1 = d.sB0 = d.sB1 = 0; d.rz0 = 0; d.cz1 = 0; d.shift = shift; d.kind = kind; d.out = out; d.out2 = nullptr; d.ldc = ldc; d.bias = bias; d.scale = scale; d.act = act; d.alpha = alpha;
    return d;
}

enum { PH_PREP = 0, PH_G1, PH_QKCONV, PH_ATTN, PH_G2, PH_LN1, PH_G3, PH_G4, PH_SOFTMAX, PH_G5, PH_G6, PH_LN2, PH_G7, PH_G8, PH_LN3, PH_COUNT };

__device__ __forceinline__ int gemm_count(int ph) {
    switch (ph) { case PH_G1: return 3; case PH_G2: case PH_G3: case PH_G4: case PH_G5: case PH_G6: case PH_G7: case PH_G8: return 1; default: return 0; }
}
__device__ __forceinline__ GemmDesc make_desc(const Params& p, int ph, int gi) {
    unsigned char* ws = p.ws;
    const bf16_t* Bh = (const bf16_t*)(ws + OFF_B);
    switch (ph) {
    case PH_G1:
        if (gi == 0) { GemmDesc d = plain_gemm(Bh, DM, (const bf16_t*)(ws + OFF_WIN), DM, MTOK, INC, DM, 0, 2, ws + OFF_T, 768, nullptr, 1.f, 0, 0.f); d.out2 = ws + OFF_U; return d; }
        if (gi == 1) return plain_gemm((const bf16_t*)(ws + OFF_MEMB), DM, (const bf16_t*)(ws + OFF_WMKV), DM, MMEM, DM, DM, 192, 0, ws + OFF_MEMK, DM, nullptr, 1.f, 0, 0.f);
        return plain_gemm((const bf16_t*)(ws + OFF_WMKV) + (size_t)DM * DM, DM, (const bf16_t*)(ws + OFF_MEMB), DM, DM, MMEM, DM, 224, 0, ws + OFF_MEMVT, MMEM, nullptr, 1.f, 0, 0.f);
    case PH_G2:
        return plain_gemm((const bf16_t*)(ws + OFF_Y), DM, (const bf16_t*)(ws + OFF_WOUT), DM, MTOK, DM, DM, 0, 3, ws + OFF_B, DM, nullptr, 1.f, 0, ALPHA);
    case PH_G3:
        return plain_gemm(Bh, DM, (const bf16_t*)(ws + OFF_WMQ), DM, MTOK, DM, DM, 0, 0, ws + OFF_Y, DM, nullptr, 1.f, 0, 0.f);
    case PH_G4: {
        GemmDesc d = plain_gemm((const bf16_t*)(ws + OFF_Y), DM, (const bf16_t*)(ws + OFF_MEMK), DM, SEQ, NMEM, 256, 0, 1, ws + OFF_T, DM, nullptr, 0.0625f, 0, 0.f);
        d.nZ = BATCH * 4; d.zdiv = 4; d.sA0 = (long)SEQ * DM; d.sA1 = 256; d.sB0 = (long)NMEM * DM; d.sB1 = 256; d.rz0 = SEQ; d.cz1 = 256; return d; }
    case PH_G5: {
        GemmDesc d = plain_gemm((const bf16_t*)(ws + OFF_Y), DM, (const bf16_t*)(ws + OFF_MEMVT), MMEM, SEQ, 256, 256, 0, 0, ws + OFF_T, DM, nullptr, 1.f, 0, 0.f);
        d.nZ = BATCH * 4; d.zdiv = 4; d.sA0 = (long)SEQ * DM; d.sA1 = 256; d.sB0 = NMEM; d.sB1 = (long)256 * MMEM; d.rz0 = SEQ; d.cz1 = 256; return d; }
    case PH_G6:
        return plain_gemm((const bf16_t*)(ws + OFF_T), DM, (const bf16_t*)(ws + OFF_WMO), DM, MTOK, DM, DM, 0, 3, ws + OFF_B, DM, nullptr, 1.f, 0, ALPHA);
    case PH_G7:
        return plain_gemm(Bh, DM, (const bf16_t*)(ws + OFF_WFF1), DM, MTOK, DFF, DM, 0, 0, ws + OFF_A1, DFF, (const float*)(ws + OFF_SMALL) + SM_BFF1, 1.f, 1, 0.f);
    default:
        return plain_gemm((const bf16_t*)(ws + OFF_A1), DFF, (const bf16_t*)(ws + OFF_WFF2), DFF, MTOK, DM, DFF, 0, 3, ws + OFF_B, DM, (const float*)(ws + OFF_SMALL) + SM_BFF2, 1.f, 0, ALPHA);
    }
}

#ifdef PROBE_TS
#define TS_STAMP(k) do { if (blockIdx.x == 0 && threadIdx.x == 0) ((volatile unsigned long long*)(ws + OFF_TS))[k] = __builtin_amdgcn_s_memrealtime(); } while (0)
#else
#define TS_STAMP(k) do { } while (0)
#endif
__global__ void __launch_bounds__(NTHR) mega(Params p) {
    extern __shared__ __attribute__((aligned(16))) unsigned char lds_raw[];
    cg::grid_group grid = cg::this_grid();
    unsigned char* ws = p.ws;
    volatile LAS unsigned* bst = (volatile LAS unsigned*)((LAS unsigned char*)lds_raw + LDS_MAIN);
    if (threadIdx.x < 4) bst[threadIdx.x] = 0u;
    __syncthreads();
    const XcdBarrier xb = xcd_barrier_post((unsigned*)(ws + OFF_BAR), bst);
    if (p.ph_lo < 0) grid.sync();
    TS_STAMP(0);
    int ph0 = p.ph_lo;
    if (ph0 == PH_PREP) {
        phase_prep(p, (char*)lds_raw);
#ifdef REPEAT_MASK
        if (REPEAT_MASK & 1) phase_prep(p, (char*)lds_raw);
#endif
        if (1 < p.ph_hi) xcd_barrier(xb);
        TS_STAMP(1);
        ph0 = 1;
    }
#pragma nounroll
    for (int ph = ph0; ph < p.ph_hi; ++ph) {
#ifdef REPEAT_MASK
#pragma nounroll
      for (int rep = 0; rep < (((REPEAT_MASK >> ph) & 1) ? 2 : 1); ++rep) {
#else
      {
#endif
        const int ng = gemm_count(ph);
        if (ng > 0) {
#pragma nounroll
            for (int gi = 0; gi < ng; ++gi) { const GemmDesc d = make_desc(p, ph, gi); gemm_phase((LAS unsigned char*)lds_raw, d); }
        } else if (ph == PH_QKCONV) {
            phase_qk(p);
            phase_conv(p, (char*)lds_raw);
        } else if (ph == PH_ATTN) {
            phase_attn(p, (char*)lds_raw);
        } else if (ph == PH_LN1) {
            ln_rows_bf16((const bf16_t*)(ws + OFF_B), (bf16_t*)(ws + OFF_B), nullptr, (const float*)(ws + OFF_SMALL) + SM_LN1G, (const float*)(ws + OFF_SMALL) + SM_LN1B);
        } else if (ph == PH_SOFTMAX) {
            phase_softmax(p);
        } else if (ph == PH_LN2) {
            ln_rows_bf16((const bf16_t*)(ws + OFF_B), (bf16_t*)(ws + OFF_B), nullptr, (const float*)(ws + OFF_SMALL) + SM_LN2G, (const float*)(ws + OFF_SMALL) + SM_LN2B);
        } else if (ph == PH_LN3) {
            ln_rows_bf16((const bf16_t*)(ws + OFF_B), nullptr, p.out, (const float*)(ws + OFF_SMALL) + SM_LN3G, (const float*)(ws + OFF_SMALL) + SM_LN3B);
        }
      }
        if (ph + 1 < p.ph_hi) xcd_barrier(xb);
        TS_STAMP(ph + 1);
    }
#ifdef PROBE_TS
    xcd_barrier(xb);
    if (blockIdx.x == 0) {
        const volatile unsigned long long* ts = (const volatile unsigned long long*)(ws + OFF_TS);
        const float da = (float)(ts[PROBE_A_HI + 1] - ts[PROBE_A_LO]) * 0.01f, db = (float)(ts[PROBE_B_HI + 1] - ts[PROBE_B_LO]) * 0.01f;
        for (int i = threadIdx.x; i < MTOK * DM; i += NTHR) p.out[i] = (i == 0) ? da * 1000.f : db;
    }
#endif
}

extern "C" void kernel_launch(void* const* d_in, const int* in_sizes, int n_in, void* d_out, int out_size, void* d_ws, size_t ws_size, hipStream_t stream) {
    static int grid = 0;
    if (grid == 0) {
        if (n_in != 27 || ws_size < WS_END) { fprintf(stderr, "kernel_launch: unexpected n_in %d / ws_size %zu (need %zu)\n", n_in, ws_size, (size_t)WS_END); grid = -1; return; }
        int dev = 0, cus = 0, per_cu = 0;
        (void)hipGetDevice(&dev);
        (void)hipDeviceGetAttribute(&cus, hipDeviceAttributeMultiprocessorCount, dev);
        if (hipFuncSetAttribute((const void*)mega, hipFuncAttributeMaxDynamicSharedMemorySize, LDS_BYTES) != hipSuccess) { fprintf(stderr, "kernel_launch: hipFuncSetAttribute failed\n"); grid = -1; return; }
        if (hipOccupancyMaxActiveBlocksPerMultiprocessor(&per_cu, (const void*)mega, NTHR, LDS_BYTES) != hipSuccess || per_cu < 1) { fprintf(stderr, "kernel_launch: occupancy query says %d\n", per_cu); per_cu = 1; }
        (void)hipGetLastError();
        grid = cus * per_cu;
        fprintf(stderr, "kernel_launch: grid %d (cus %d x %d)\n", grid, cus, per_cu);
    }
    if (grid < 0) return;
    Params p{};
    for (int i = 0; i < 27; ++i) p.in[i] = (const float*)d_in[i];
    p.out = (float*)d_out; p.ws = (unsigned char*)d_ws; p.ph_lo = 0; p.ph_hi = PH_COUNT;
    if (hipMemsetAsync((char*)d_ws + OFF_BAR, 0, BAR_BYTES, stream) != hipSuccess) { fprintf(stderr, "kernel_launch: memset failed\n"); return; }
    void* args[] = {&p};
    hipError_t e = hipLaunchCooperativeKernel((const void*)mega, dim3(grid), dim3(NTHR), args, LDS_BYTES, stream);
    if (e != hipSuccess) fprintf(stderr, "kernel_launch: cooperative launch failed: %s (grid %d)\n", hipGetErrorString(e), grid);
}
```
